# Optimizing an MI355X kernel written in HIP

```python
import math
import jax, jax.numpy as jnp
from jax import lax
import numpy as np

D_MODEL = 2048
BATCH = 8
SEQ = 2048
DEPTH = 4

NORM_EPS = 1e-6
GDN_HEADS = 16
GDN_HEAD_DIM = D_MODEL // GDN_HEADS
GDN_CONV = 4
GDN_CHUNK = 64
GDN_WIDTH = GDN_HEADS * GDN_HEAD_DIM
GDN_PROJ = 4 * GDN_WIDTH + 2 * GDN_HEADS
NSA_HEADS = 16
NSA_GROUPS = 4
NSA_HPG = NSA_HEADS // NSA_GROUPS
NSA_HEAD_DIM = D_MODEL // NSA_HEADS
NSA_KV_WIDTH = NSA_GROUPS * NSA_HEAD_DIM
NSA_N_BRANCH = 3
CMP_BLOCK = 32
CMP_STRIDE = 16
CMP_HIDDEN = 512
SEL_BLOCK = 64
SEL_TOPK = 16
WINDOW = 512
NSA_QBLOCK = 64
BIG = 1e9
ROPE_THETA = 500000.0
ROPE_DIM = NSA_HEAD_DIM // 4
FFN_DIM = 5632
N_EXPERTS = 8
TOP_K = 2
EXPERT_DIM = 2048

kernel_name = 'hybrid_gdn_nsa_yoco_moe'


def rmsnorm(x, w):
    xf = x.astype(jnp.float32)
    y = xf * lax.rsqrt(jnp.mean(xf * xf, axis=-1, keepdims=True) + NORM_EPS)
    return (y * w.astype(jnp.float32)).astype(x.dtype)


def l2norm(x):
    xf = x.astype(jnp.float32)
    return xf * lax.rsqrt(jnp.sum(xf * xf, axis=-1, keepdims=True) + NORM_EPS)


def causal_conv(x, w):
    k_width = w.shape[0]
    s = x.shape[1]
    xp = jnp.pad(x, ((0, 0), (k_width - 1, 0), (0, 0)))
    y = xp[:, 0:s] * w[0]
    for j in range(1, k_width):
        y = y + xp[:, j:j + s] * w[j]
    return y


def masked_softmax(s, mask):
    s = jnp.where(mask, s.astype(jnp.float32), -jnp.inf)
    m = jnp.max(s, axis=-1, keepdims=True)
    m = jnp.where(jnp.isfinite(m), m, 0.0)
    p = jnp.where(mask, jnp.exp(s - m), 0.0)
    return p / jnp.maximum(jnp.sum(p, axis=-1, keepdims=True), 1e-30)


def swiglu(h, w_gate, w_up, w_down):
    return (jax.nn.silu(h @ w_gate) * (h @ w_up)) @ w_down


def rope_tables(positions):
    inv = ROPE_THETA ** (-jnp.arange(0, ROPE_DIM, 2, dtype=jnp.float32) / ROPE_DIM)
    ang = positions.astype(jnp.float32)[..., None] * inv
    return jnp.cos(ang)[:, :, None, :], jnp.sin(ang)[:, :, None, :]


def apply_rope(x, cos, sin):
    half = ROPE_DIM // 2
    x1 = x[..., :half].astype(jnp.float32)
    x2 = x[..., half:ROPE_DIM].astype(jnp.float32)
    rot = jnp.concatenate([x1 * cos - x2 * sin, x2 * cos + x1 * sin], axis=-1).astype(x.dtype)
    return jnp.concatenate([rot, x[..., ROPE_DIM:]], axis=-1)


def chunk_gated_delta(q, k, v, g, beta):
    b, s, h, dk = q.shape
    dv = v.shape[-1]
    c = GDN_CHUNK
    n = s // c

    def chunks(t):
        return t.reshape(b, n, c, h, -1).transpose(1, 0, 3, 2, 4)

    q = chunks(q) * (dk ** -0.5)
    k = chunks(k)
    v = chunks(v)
    g = g.reshape(b, n, c, h).transpose(1, 0, 3, 2)
    beta = beta.reshape(b, n, c, h).transpose(1, 0, 3, 2)
    gc = jnp.cumsum(g, axis=-1)
    tril = jnp.tril(jnp.ones((c, c), dtype=bool))
    strict = jnp.tril(jnp.ones((c, c), dtype=bool), -1)
    decay = jnp.exp(jnp.where(tril, gc[..., :, None] - gc[..., None, :], -jnp.inf))
    k_beta = k * beta[..., None]
    v_beta = v * beta[..., None]
    lower = jnp.where(strict, jnp.einsum('nbhid,nbhjd->nbhij', k_beta, k) * decay, 0.0)
    eye = jnp.eye(c, dtype=jnp.float32)
    t_inv = lax.linalg.triangular_solve(eye + lower, jnp.broadcast_to(eye, lower.shape),
                                        left_side=True, lower=True, unit_diagonal=True)
    u = t_inv @ v_beta
    w = t_inv @ (k_beta * jnp.exp(gc)[..., None])
    a_qk = jnp.einsum('nbhid,nbhjd->nbhij', q, k) * decay
    q_dec = q * jnp.exp(gc)[..., None]
    k_dec = k * jnp.exp(gc[..., -1:] - gc)[..., None]
    g_last = jnp.exp(gc[..., -1])

    def step(state, xs):
        u_i, w_i, q_i, k_i, a_i, gl_i = xs
        v_new = u_i - w_i @ state
        o_i = q_i @ state + a_i @ v_new
        state = state * gl_i[..., None, None] + jnp.swapaxes(k_i, -1, -2) @ v_new
        return state, o_i

    state0 = jnp.zeros((b, h, dk, dv), jnp.float32)
    _, o = lax.scan(step, state0, (u, w, q_dec, k_dec, a_qk, g_last))
    return o.transpose(1, 0, 3, 2, 4).reshape(b, s, h, dv)


def gated_deltanet(h, w_in, conv_w, a_log, dt_bias, out_norm, w_out):
    b, s, _ = h.shape
    proj = h @ w_in
    qkv = jax.nn.silu(causal_conv(proj[..., :3 * GDN_WIDTH], conv_w))
    z = proj[..., 3 * GDN_WIDTH:4 * GDN_WIDTH]
    beta_logit = proj[..., 4 * GDN_WIDTH:4 * GDN_WIDTH + GDN_HEADS]
    a = proj[..., 4 * GDN_WIDTH + GDN_HEADS:]
    q, k, v = [t.reshape(b, s, GDN_HEADS, GDN_HEAD_DIM) for t in jnp.split(qkv, 3, axis=-1)]
    q = l2norm(q)
    k = l2norm(k)
    beta = jax.nn.sigmoid(beta_logit.astype(jnp.float32))
    g = -jnp.exp(a_log.astype(jnp.float32)) * jax.nn.softplus(a.astype(jnp.float32) + dt_bias.astype(jnp.float32))
    o = chunk_gated_delta(q, k, v.astype(jnp.float32), g, beta)
    o = rmsnorm(o, out_norm) * jax.nn.silu(z.reshape(b, s, GDN_HEADS, GDN_HEAD_DIM).astype(jnp.float32))
    return o.reshape(b, s, GDN_WIDTH).astype(h.dtype) @ w_out


def nsa_shared_kv(h, positions, kv_norm, w_kv, cmp_pos_k, cmp_w1_k, cmp_w2_k, cmp_pos_v, cmp_w1_v, cmp_w2_v):
    b, s, _ = h.shape
    kv = rmsnorm(h, kv_norm) @ w_kv
    kc, vc, ks, vs, kw, vw = [t.reshape(b, s, NSA_GROUPS, NSA_HEAD_DIM) for t in jnp.split(kv, 6, axis=-1)]
    cos, sin = rope_tables(positions)
    ks = apply_rope(ks, cos, sin)
    kw = apply_rope(kw, cos, sin)
    n_cmp = (s - CMP_BLOCK) // CMP_STRIDE + 1
    blk_idx = CMP_STRIDE * jnp.arange(n_cmp)[:, None] + jnp.arange(CMP_BLOCK)[None, :]

    def compress(t, pos, w1, w2):
        blk = t[:, blk_idx] + pos[:, None, :]
        blk = blk.transpose(0, 3, 1, 2, 4).reshape(b, NSA_GROUPS, n_cmp, CMP_BLOCK * NSA_HEAD_DIM)
        return jax.nn.silu(blk @ w1) @ w2

    k_cmp = compress(kc, cmp_pos_k, cmp_w1_k, cmp_w2_k)
    v_cmp = compress(vc, cmp_pos_v, cmp_w1_v, cmp_w2_v)
    n_sel = s // SEL_BLOCK
    to_bg = lambda t: t.transpose(0, 2, 1, 3)
    k_sel = to_bg(ks).reshape(b, NSA_GROUPS, n_sel, SEL_BLOCK, NSA_HEAD_DIM)
    v_sel = to_bg(vs).reshape(b, NSA_GROUPS, n_sel, SEL_BLOCK, NSA_HEAD_DIM)
    pad = ((0, 0), (0, 0), (WINDOW, 0), (0, 0))
    k_win = jnp.pad(to_bg(kw), pad)
    v_win = jnp.pad(to_bg(vw), pad)
    return k_cmp, v_cmp, k_sel, v_sel, k_win, v_win


def nsa_attention(h, positions, w_q, w_o, shared):
    k_cmp, v_cmp, k_sel, v_sel, k_win, v_win = shared
    b, s, _ = h.shape
    dh = NSA_HEAD_DIM
    qg = h @ w_q
    q = qg[..., :NSA_HEADS * dh].reshape(b, s, NSA_HEADS, dh)
    gates = jax.nn.sigmoid(qg[..., NSA_HEADS * dh:].astype(jnp.float32)).reshape(b, s, NSA_HEADS, NSA_N_BRANCH)
    cos, sin = rope_tables(positions)
    q_rot = apply_rope(q, cos, sin)
    by_group = lambda t: t.reshape(b, s, NSA_GROUPS, NSA_HPG, t.shape[-1]).transpose(0, 2, 3, 1, 4)
    q, q_rot, gates = by_group(q), by_group(q_rot), by_group(gates)
    n_cmp = k_cmp.shape[2]
    n_sel = k_sel.shape[2]
    topk = min(SEL_TOPK, n_sel)
    scale = dh ** -0.5
    c_idx = jnp.arange(n_cmp)
    j_idx = jnp.arange(n_sel)
    cmp_end = c_idx * CMP_STRIDE + CMP_BLOCK - 1
    overlap = jnp.clip(jnp.minimum(c_idx[:, None] * CMP_STRIDE + CMP_BLOCK, (j_idx[None, :] + 1) * SEL_BLOCK)
                       - jnp.maximum(c_idx[:, None] * CMP_STRIDE, j_idx[None, :] * SEL_BLOCK), 0).astype(jnp.float32) / CMP_STRIDE
    bi = jnp.arange(b)[:, None, None, None]
    gi = jnp.arange(NSA_GROUPS)[None, :, None, None]
    r_idx = jnp.arange(SEL_BLOCK)
    qb_len = NSA_QBLOCK

    def block(n):
        t0 = n * qb_len
        t = t0 + jnp.arange(qb_len)
        qb = lax.dynamic_slice_in_dim(q, t0, qb_len, axis=3)
        qr = lax.dynamic_slice_in_dim(q_rot, t0, qb_len, axis=3)
        gb = lax.dynamic_slice_in_dim(gates, t0, qb_len, axis=3)
        s_c = jnp.einsum('bghqd,bgcd->bghqc', qb, k_cmp) * scale
        p_c = masked_softmax(s_c, cmp_end[None, :] <= t[:, None])
        o_c = jnp.einsum('bghqc,bgcd->bghqd', p_c, v_cmp.astype(jnp.float32))
        imp = jnp.einsum('bghqc,cj->bgqj', p_c, overlap)
        cur = t // SEL_BLOCK
        forced = (j_idx[None, :] == 0) | (j_idx[None, :] == cur[:, None]) | (j_idx[None, :] == cur[:, None] - 1)
        causal = j_idx[None, :] * SEL_BLOCK <= t[:, None]
        score = jnp.where(forced, BIG, jnp.where(causal, imp, -BIG))
        _, sel = lax.top_k(score, topk)
        k_g = k_sel[bi, gi, sel]
        v_g = v_sel[bi, gi, sel]
        tok = sel[..., None] * SEL_BLOCK + r_idx
        mask_s = (tok <= t[None, None, :, None, None]).reshape(b, NSA_GROUPS, 1, qb_len, topk * SEL_BLOCK)
        s_s = jnp.einsum('bghqd,bgqnrd->bghqnr', qr, k_g).reshape(b, NSA_GROUPS, NSA_HPG, qb_len, topk * SEL_BLOCK) * scale
        p_s = masked_softmax(s_s, mask_s).reshape(b, NSA_GROUPS, NSA_HPG, qb_len, topk, SEL_BLOCK)
        o_s = jnp.einsum('bghqnr,bgqnrd->bghqd', p_s, v_g.astype(jnp.float32))
        k_w = lax.dynamic_slice_in_dim(k_win, t0, qb_len + WINDOW, axis=2)
        v_w = lax.dynamic_slice_in_dim(v_win, t0, qb_len + WINDOW, axis=2)
        s_pos = t0 - WINDOW + jnp.arange(qb_len + WINDOW)
        mask_w = (s_pos[None, :] <= t[:, None]) & (s_pos[None, :] > t[:, None] - WINDOW) & (s_pos[None, :] >= 0)
        s_w = jnp.einsum('bghqd,bgkd->bghqk', qr, k_w) * scale
        p_w = masked_softmax(s_w, mask_w)
        o_w = jnp.einsum('bghqk,bgkd->bghqd', p_w, v_w.astype(jnp.float32))
        return gb[..., 0:1] * o_c + gb[..., 1:2] * o_s + gb[..., 2:3] * o_w

    o = lax.map(block, jnp.arange(s // qb_len))
    o = o.transpose(1, 0, 4, 2, 3, 5).reshape(b, s, NSA_HEADS * dh).astype(h.dtype)
    return o @ w_o


def moe_ffn(h, router, w_gate, w_up, w_down):
    b, s, d = h.shape
    tok = h.reshape(b * s, d)
    probs = jax.nn.softmax((tok @ router).astype(jnp.float32), axis=-1)
    top_p, top_i = lax.top_k(probs, TOP_K)
    top_p = top_p / jnp.sum(top_p, axis=-1, keepdims=True)
    comb = jnp.sum(jax.nn.one_hot(top_i, N_EXPERTS, dtype=jnp.float32) * top_p[..., None], axis=1)
    out = jnp.zeros((b * s, d), jnp.float32)
    for e in range(N_EXPERTS):
        out = out + comb[:, e:e + 1] * swiglu(tok, w_gate[e], w_up[e], w_down[e]).astype(jnp.float32)
    return out.reshape(b, s, d).astype(h.dtype)


def setup_inputs(seed: int = 0) -> dict:
    key = jax.random.key(seed)
    keys = iter(jax.random.split(key, 32))
    f32 = jnp.float32
    n_a = DEPTH // 2
    n_b = DEPTH - n_a
    n_dense = (DEPTH + 1) // 2
    n_moe = DEPTH // 2

    def nrm(shape, fan_in):
        return jax.random.normal(next(keys), shape, f32) * fan_in ** -0.5

    def gain(shape):
        return 1.0 + 0.02 * jax.random.normal(next(keys), shape, f32)

    x = jax.random.normal(next(keys), (BATCH, SEQ, D_MODEL), f32)
    positions = jnp.arange(SEQ, dtype=jnp.int32)[None, :] + jax.random.randint(next(keys), (BATCH, 1), 0, 4096, dtype=jnp.int32)
    a_log = jnp.log(jax.random.uniform(next(keys), (n_a, GDN_HEADS), f32, 1.0, 16.0))
    dt = jnp.exp(jax.random.uniform(next(keys), (n_a, GDN_HEADS), f32, math.log(1e-3), math.log(1e-1)))
    dt_bias = dt + jnp.log(-jnp.expm1(-dt))
    return {
        'x': x,
        'positions': positions,
        'attn_norm': gain((DEPTH, D_MODEL)),
        'ffn_norm': gain((DEPTH, D_MODEL)),
        'final_norm': gain((D_MODEL,)),
        'gdn_w_in': nrm((n_a, D_MODEL, GDN_PROJ), D_MODEL),
        'gdn_conv': nrm((n_a, GDN_CONV, 3 * GDN_WIDTH), GDN_CONV),
        'gdn_a_log': a_log,
        'gdn_dt_bias': dt_bias,
        'gdn_out_norm': gain((n_a, GDN_HEAD_DIM)),
        'gdn_w_out': nrm((n_a, GDN_WIDTH, D_MODEL), GDN_WIDTH),
        'kv_norm': gain((D_MODEL,)),
        'nsa_w_kv': nrm((D_MODEL, 6 * NSA_KV_WIDTH), D_MODEL),
        'cmp_pos_k': 0.02 * jax.random.normal(next(keys), (CMP_BLOCK, NSA_HEAD_DIM), f32),
        'cmp_w1_k': nrm((CMP_BLOCK * NSA_HEAD_DIM, CMP_HIDDEN), CMP_BLOCK * NSA_HEAD_DIM),
        'cmp_w2_k': nrm((CMP_HIDDEN, NSA_HEAD_DIM), CMP_HIDDEN),
        'cmp_pos_v': 0.02 * jax.random.normal(next(keys), (CMP_BLOCK, NSA_HEAD_DIM), f32),
        'cmp_w1_v': nrm((CMP_BLOCK * NSA_HEAD_DIM, CMP_HIDDEN), CMP_BLOCK * NSA_HEAD_DIM),
        'cmp_w2_v': nrm((CMP_HIDDEN, NSA_HEAD_DIM), CMP_HIDDEN),
        'nsa_w_q': nrm((n_b, D_MODEL, NSA_HEADS * NSA_HEAD_DIM + NSA_HEADS * NSA_N_BRANCH), D_MODEL),
        'nsa_w_o': nrm((n_b, NSA_HEADS * NSA_HEAD_DIM, D_MODEL), NSA_HEADS * NSA_HEAD_DIM),
        'ffn_w_gate': nrm((n_dense, D_MODEL, FFN_DIM), D_MODEL),
        'ffn_w_up': nrm((n_dense, D_MODEL, FFN_DIM), D_MODEL),
        'ffn_w_down': nrm((n_dense, FFN_DIM, D_MODEL), FFN_DIM),
        'moe_router': nrm((n_moe, D_MODEL, N_EXPERTS), D_MODEL),
        'moe_w_gate': nrm((n_moe, N_EXPERTS, D_MODEL, EXPERT_DIM), D_MODEL),
        'moe_w_up': nrm((n_moe, N_EXPERTS, D_MODEL, EXPERT_DIM), D_MODEL),
        'moe_w_down': nrm((n_moe, N_EXPERTS, EXPERT_DIM, D_MODEL), EXPERT_DIM),
    }


def reference(x, positions, attn_norm, ffn_norm, final_norm, gdn_w_in, gdn_conv, gdn_a_log, gdn_dt_bias,
              gdn_out_norm, gdn_w_out, kv_norm, nsa_w_kv, cmp_pos_k, cmp_w1_k, cmp_w2_k, cmp_pos_v, cmp_w1_v,
              cmp_w2_v, nsa_w_q, nsa_w_o, ffn_w_gate, ffn_w_up, ffn_w_down, moe_router, moe_w_gate, moe_w_up,
              moe_w_down):
    n_a = DEPTH // 2
    h = x
    shared = None
    for l in range(DEPTH):
        hn = rmsnorm(h, attn_norm[l])
        if l < n_a:
            h = h + gated_deltanet(hn, gdn_w_in[l], gdn_conv[l], gdn_a_log[l], gdn_dt_bias[l], gdn_out_norm[l], gdn_w_out[l])
        else:
            h = h + nsa_attention(hn, positions, nsa_w_q[l - n_a], nsa_w_o[l - n_a], shared)
        hn = rmsnorm(h, ffn_norm[l])
        if l % 2 == 0:
            h = h + swiglu(hn, ffn_w_gate[l // 2], ffn_w_up[l // 2], ffn_w_down[l // 2])
        else:
            h = h + moe_ffn(hn, moe_router[l // 2], moe_w_gate[l // 2], moe_w_up[l // 2], moe_w_down[l // 2])
        if l == n_a - 1:
            shared = nsa_shared_kv(h, positions, kv_norm, nsa_w_kv, cmp_pos_k, cmp_w1_k, cmp_w2_k,
                                   cmp_pos_v, cmp_w1_v, cmp_w2_v)
    return rmsnorm(h, final_norm)
```

```cpp
#include <hip/hip_runtime.h>
#include <stdint.h>
#include <stdio.h>

#define LAS __attribute__((address_space(3)))
typedef unsigned short bf16_t;
typedef short bf16x8 __attribute__((ext_vector_type(8)));
typedef float f32x4 __attribute__((ext_vector_type(4)));
typedef float f32x2 __attribute__((ext_vector_type(2)));
typedef unsigned u32x4 __attribute__((ext_vector_type(4)));
typedef unsigned u32x2 __attribute__((ext_vector_type(2)));
typedef __bf16 bfx2_t __attribute__((ext_vector_type(2)));
#define DI __device__ __forceinline__

constexpr int M_TOK = 16384, DM = 2048, NB = 8, SEQ = 2048;
constexpr int FFN = 5632, NEXP = 8, EDIM = 2048;
constexpr int NTHREADS = 512, NWAVES = 8;
constexpr float NORM_EPS = 1e-6f;
constexpr int MAX_SLOTS = 32768 + 8 * 256;

constexpr size_t MiB = 1024ull * 1024ull;
constexpr size_t WS_CTL = 0;
constexpr size_t WS_H = 1 * MiB;
constexpr size_t WS_WB = WS_H + 128 * MiB;
constexpr size_t WS_WKV = WS_WB + 234 * MiB;
constexpr size_t WS_SKV = WS_WKV + 24 * MiB;
constexpr size_t WS_AUX = WS_SKV + 100 * MiB;
constexpr size_t WS_SL = WS_AUX + 16 * MiB;
constexpr size_t SLOT = 64 * MiB;
constexpr size_t WS_END = WS_SL + 12 * SLOT;
constexpr size_t WB_MIX_IN = 0;
constexpr size_t WB_SMALL = 32 * MiB;
constexpr size_t WB_MIX_OUT = 33 * MiB;
constexpr size_t WB_FFN = 41 * MiB;
constexpr size_t WB_FFN_DOWN_DENSE = WB_FFN + 44 * MiB;
constexpr size_t WB_MOE_DOWN = WB_FFN + 128 * MiB;
constexpr size_t WB_ROUTER = WB_FFN + 192 * MiB;
constexpr size_t WKV_KV = 0;
constexpr size_t WKV_W1K = 12 * MiB;
constexpr size_t WKV_W1V = 16 * MiB;
constexpr size_t WKV_BIASK = 20 * MiB;
constexpr size_t WKV_BIASV = 20 * MiB + 4096;
constexpr size_t WKV_BPART = 20 * MiB + 512 * 1024;
constexpr size_t WKV_W2K = 20 * MiB + 64 * 1024, WKV_W2V = 20 * MiB + 192 * 1024;
constexpr size_t WKV_ROPE = 21 * MiB;
constexpr size_t SKV_T = 16 * MiB;
constexpr size_t SKV_KCMP = 96 * MiB, SKV_VCMP = 97 * MiB;
constexpr size_t AUX_SK = 0;
constexpr size_t AUX_G = 3 * MiB, AUX_BETA = 4 * MiB;
constexpr size_t AUX_RL = 5 * MiB;
constexpr size_t AUX_TOKE = AUX_RL + 512 * 1024, AUX_TOKR = AUX_TOKE + 128 * 1024, AUX_TOKW = AUX_TOKR + 128 * 1024, AUX_SLOTOF = AUX_TOKW + 128 * 1024;
constexpr size_t AUX_ROWW = 6 * MiB, AUX_TOKOF = 7 * MiB;
constexpr size_t AUX_HK = 8 * MiB, AUX_HV = 12 * MiB;
constexpr int CW_BAR = 0;
constexpr int CW_MOECNT = 4096;
constexpr int CW_TILEE = 4352;
constexpr int CTL_ZERO_BYTES = 32768;
static_assert(WB_ROUTER + 256 * 1024 <= 234 * MiB, "wb");

#define MFMA32(a, b, c) __builtin_amdgcn_mfma_f32_32x32x16_bf16((a), (b), (c), 0, 0, 0)
#define MFMA16(a, b, c) __builtin_amdgcn_mfma_f32_16x16x32_bf16((a), (b), (c), 0, 0, 0)
DI float bf2f(bf16_t v) { return __uint_as_float(((unsigned)v) << 16); }
DI unsigned pack2(float lo, float hi) { bfx2_t v; v.x = (__bf16)lo; v.y = (__bf16)hi; return __builtin_bit_cast(unsigned, v); }
DI bf16_t f2bf(float f) { __bf16 b = (__bf16)f; return __builtin_bit_cast(unsigned short, b); }
DI float lo2f(unsigned w) { return __uint_as_float(w << 16); }
DI float hi2f(unsigned w) { return __uint_as_float(w & 0xffff0000u); }
template <int O> DI float xor_f(float v) {
    if constexpr (O == 32) { auto r = __builtin_amdgcn_permlane32_swap(__float_as_uint(v), __float_as_uint(v), false, false); return __uint_as_float(r[0]) == v ? __uint_as_float(r[1]) : __uint_as_float(r[0]); }
    else return __uint_as_float((unsigned)__builtin_amdgcn_ds_swizzle((int)__float_as_uint(v), (O << 10) | 0x1F));
}
DI float wave_sum(float v) {
    v += xor_f<1>(v); v += xor_f<2>(v); v += xor_f<4>(v); v += xor_f<8>(v); v += xor_f<16>(v);
    { auto r = __builtin_amdgcn_permlane32_swap(__float_as_uint(v), __float_as_uint(v), false, false); v = __uint_as_float(r[0]) + __uint_as_float(r[1]); }
    return v; }
DI float wave_max(float v) {
    v = fmaxf(v, xor_f<1>(v)); v = fmaxf(v, xor_f<2>(v)); v = fmaxf(v, xor_f<4>(v)); v = fmaxf(v, xor_f<8>(v)); v = fmaxf(v, xor_f<16>(v));
    { auto r = __builtin_amdgcn_permlane32_swap(__float_as_uint(v), __float_as_uint(v), false, false); v = fmaxf(__uint_as_float(r[0]), __uint_as_float(r[1])); }
    return v; }
DI int lane_id() { int l; asm volatile("v_mbcnt_lo_u32_b32 %0, -1, 0\n\tv_mbcnt_hi_u32_b32 %0, -1, %0" : "=v"(l)); return l; }
DI float fast_sigmoid(float x) { return __builtin_amdgcn_rcpf(1.0f + __expf(-x)); }
DI float silu_f(float x) { return x * __builtin_amdgcn_rcpf(1.0f + __expf(-x)); }

#define XB_TMO      128
#define XB_XCNT(j)  (256  + 64 * (j))
#define XB_XSUB(j)  (1280 + 64 * (j))
#define XB_XGEN(j)  (2304 + 64 * (j))
#define XB_TOP      3328
#define XB_TOPGEN   3392
#define XCD_BAR_WORDS 3456
#define XB_SPIN_CAP (1u << 22)
DI unsigned xb_ld(unsigned* p)              { return __hip_atomic_load(p, __ATOMIC_RELAXED, __HIP_MEMORY_SCOPE_AGENT); }
DI unsigned xb_add(unsigned* p, unsigned v) { return __hip_atomic_fetch_add(p, v, __ATOMIC_RELAXED, __HIP_MEMORY_SCOPE_AGENT); }
DI unsigned xb_xcc_id() { return (unsigned)__builtin_amdgcn_s_getreg((3 << 11) | 20) & 0xFu; }
#define XB_SPIN(cond, bar) do { unsigned _sp = 0; while (cond) { __builtin_amdgcn_s_sleep(1); \
    if ((++_sp & 255u) == 0u) { if (xb_ld(&(bar)[XB_TMO])) break; if (_sp > XB_SPIN_CAP) { atomicAdd(&(bar)[XB_TMO], 1u); break; } } } } while (0)
struct XcdBarrier { unsigned* bar; unsigned x; volatile LAS unsigned* st; };
DI XcdBarrier xcd_barrier_post(unsigned* bar, volatile LAS unsigned* st, int tid) {
    XcdBarrier b; b.bar = bar; b.x = xb_xcc_id(); b.st = st;
    if (tid == 0) (void)xb_add(&bar[XB_XCNT(b.x)], 1u);
    return b;
}
DI void xcd_barrier_complete(unsigned* bar, unsigned x, unsigned& nloc, unsigned& nx) {
    const unsigned G = gridDim.x * gridDim.y * gridDim.z;
    unsigned sum, cnt, mine, sp = 0u;
    for (;;) {
        sum = 0u; cnt = 0u; mine = 0u;
#pragma unroll
        for (unsigned j = 0; j < 16; ++j) { const unsigned c = xb_ld(&bar[XB_XCNT(j)]); sum += c; cnt += (c > 0u) ? 1u : 0u; mine = (j == x) ? c : mine; }
        if (sum == G) break;
        __builtin_amdgcn_s_sleep(1);
        if ((++sp & 255u) == 0u) { if (xb_ld(&bar[XB_TMO])) break; if (sp > XB_SPIN_CAP) { atomicAdd(&bar[XB_TMO], 1u); break; } }
    }
    nloc = mine > 0u ? mine : 1u; nx = cnt > 0u ? cnt : 1u;
}
DI void xcd_barrier(const XcdBarrier& b, int tid) {
    asm volatile("s_waitcnt vmcnt(0)" ::: "memory");
    __syncthreads();
    if (tid == 0) {
        unsigned* bar = b.bar;
        __builtin_amdgcn_s_waitcnt(0);
        unsigned nloc = b.st[0], nx = b.st[1];
        if (nloc == 0u) { xcd_barrier_complete(bar, b.x, nloc, nx); b.st[0] = nloc; b.st[1] = nx; }
        const unsigned old = xb_add(&bar[XB_XSUB(b.x)], 1u);
        const unsigned gen = old / nloc;
        if (old + 1u == (gen + 1u) * nloc) {
            __builtin_amdgcn_fence(__ATOMIC_RELEASE, "agent");
            asm volatile("s_waitcnt vmcnt(0)" ::: "memory");
            const unsigned og = xb_add(&bar[XB_TOP], 1u);
            const unsigned tg = og / nx;
            if (og + 1u == (tg + 1u) * nx) xb_add(&bar[XB_TOPGEN], 1u);
            else XB_SPIN(xb_ld(&bar[XB_TOPGEN]) == tg, bar);
            __builtin_amdgcn_fence(__ATOMIC_ACQUIRE, "agent");
            xb_add(&bar[XB_XGEN(b.x)], 1u);
            asm volatile("s_waitcnt vmcnt(0)" ::: "memory");
        } else {
            XB_SPIN(xb_ld(&bar[XB_XGEN(b.x)]) == gen, bar);
            __builtin_amdgcn_fence(__ATOMIC_ACQUIRE, "agent");
            asm volatile("s_waitcnt vmcnt(0)" ::: "memory");
        }
    }
    __syncthreads();
}

namespace pg8 {
constexpr int BM = 256, BK = 64, HALF = 128, HTB = HALF * BK * 2, STAGE_BYTES = 8 * HTB, NXCD = 8, WGM = 8;
__host__ __device__ __forceinline__ int lds_byte(int r, int c) { const int st = (r >> 4) * 2 + (c >> 5), rr = r & 15, cc = c & 31, ob = rr * 64 + cc * 2; return st * 1024 + (ob ^ (((ob >> 9) & 1) << 5)); }
__host__ __device__ __forceinline__ void stage_rc(int b, int& R, int& C) { const int st = b / 1024, sb = b % 1024, swz = sb ^ (((sb >> 9) & 1) << 5); R = (st >> 1) * 16 + swz / 64; C = (st & 1) * 32 + (swz % 64) / 2; }
__host__ __device__ __forceinline__ int perm32(int rho) { const int n = rho >> 4, i = rho & 15; return 8 * (i >> 2) + 4 * n + (i & 3); }
struct Unit { int pm, pn, aux; const char* A; const char* B; };
struct Gemm { int K, lda, ldb; };
DI bool static_map(int i, int G, int c, int nM, int nN, int& pm, int& pn) {
    const int nwg = nM * nN; const long L = (long)i * G + c; if (L >= nwg) return false;
    int wgid = (int)L; { const int q = nwg / NXCD, r = nwg % NXCD, xcd = wgid % NXCD, off = wgid / NXCD; wgid = (xcd < r ? xcd * (q + 1) : r * (q + 1) + (xcd - r) * q) + off; }
    const int nig = WGM * nN, gid = wgid / nig, fm = gid * WGM, gsz = (nM - fm) < WGM ? (nM - fm) : WGM;
    pm = fm + ((wgid % nig) % gsz); pn = (wgid % nig) / gsz; return true;
}
struct SchedDense {
    int nM, nN, G, c; const char* A; const char* B; size_t astep, bstep;
    DI void init(int M, int N, int G_, int c_, const void* A_, int lda, const void* B_, int ldb) { nM = M / BM; nN = N / BM; G = G_; c = c_; A = (const char*)A_; B = (const char*)B_; astep = (size_t)BM * lda * 2; bstep = (size_t)BM * ldb * 2; }
    DI bool next(int i, Unit& u) const { if (!static_map(i, G, c, nM, nN, u.pm, u.pn)) return false; u.aux = 0; u.A = A + (size_t)u.pm * astep; u.B = B + (size_t)u.pn * bstep; return true; }
    DI void a_ready(const Unit&) const {}
    DI void done(const Unit&) const {}
};
struct SchedMoe {
    int nM, nN, G, c; const char* A; const char* B; size_t astep, bstep, estep; const int* tile_e;
    DI bool next(int i, Unit& u) const { if (!static_map(i, G, c, nM, nN, u.pm, u.pn)) return false; u.aux = tile_e[u.pm]; u.A = A + (size_t)u.pm * astep; u.B = B + (size_t)u.aux * estep + (size_t)u.pn * bstep; return true; }
    DI void a_ready(const Unit&) const {}
    DI void done(const Unit&) const {}
};
DI void static_map_L(int L, int nM, int nN, int& pm, int& pn) {
    const int nwg = nM * nN; int wgid = L; { const int q = nwg / NXCD, r = nwg % NXCD, xcd = wgid % NXCD, off = wgid / NXCD; wgid = (xcd < r ? xcd * (q + 1) : r * (q + 1) + (xcd - r) * q) + off; }
    const int nig = WGM * nN, gid = wgid / nig, fm = gid * WGM, gsz = (nM - fm) < WGM ? (nM - fm) : WGM;
    pm = fm + ((wgid % nig) % gsz); pn = (wgid % nig) / gsz;
}
struct SchedMoe2 {
    int g0, g1, d0, d1, G, c; const char* Ag; const char* Bg; const char* Ad; const char* Bd; const int* tile_e; const int* tokof;
    DI bool next(int i, Unit& u) const {
        const int NG = (g1 - g0) * 16, ND = (d1 - d0) * 8; const int L = i * G + c; if (L >= NG + ND) return false;
        if (L < NG) { static_map_L(L, g1 - g0, 16, u.pm, u.pn); u.pm += g0; const int e = tile_e[u.pm]; u.aux = e;
            u.A = Ag; u.B = Bg + (size_t)e * 4096 * 2048 * 2 + (size_t)u.pn * 256 * 2048 * 2; }
        else { static_map_L(L - NG, d1 - d0, 8, u.pm, u.pn); u.pm += d0; const int e = tile_e[u.pm]; u.aux = e | 256;
            u.A = Ad; u.B = Bd + (size_t)e * 2048 * 2048 * 2 + (size_t)u.pn * 256 * 2048 * 2; }
        return true; }
    DI unsigned a_off(const Unit& u, int R, int C) const { const int slot = u.pm * 256 + R; const int row = (u.aux & 256) ? slot : tokof[slot]; return (unsigned)(row * 2048 + C) * 2u; }
    DI void a_ready(const Unit&) const {}
    DI void done(const Unit&) const {}
};
struct SchedCmp {
    int G, c; const char* A0; const char* A1; const char* B0; const char* B1;
    DI bool next(int i, Unit& u) const { const int L = i * G + c; if (L >= 256) return false; const int p = L >> 7, ks = (L >> 5) & 3, r = L & 31; u.aux = p * 4 + ks; u.pm = r & 15; u.pn = r >> 4;
        u.A = (p ? A1 : A0) + (size_t)u.pm * 256 * 2048 * 2 + (size_t)ks * 1024 * 2; u.B = (p ? B1 : B0) + (size_t)u.pn * 256 * 4096 * 2 + (size_t)ks * 1024 * 2; return true; }
    DI void a_ready(const Unit&) const {}
    DI void done(const Unit&) const {}
};

typedef f32x4 Acc[2][2][4][2];
struct EpiRes {
    static constexpr bool PERM = true;
    const void* base; bf16_t* out; int ldc; bool base_f32;
    DI void operator()(const Acc& acc, const Unit& u, int wr, int wc, int fr, int fq) const {
        const int row0 = u.pm * BM + wr * 64 + fr, col0 = u.pn * BM + wc * 32 + 8 * fq;
#pragma unroll
        for (int ai = 0; ai < 2; ++ai)
#pragma unroll
            for (int m = 0; m < 4; ++m) { const size_t off = (size_t)(row0 + ai * HALF + m * 16) * ldc + col0;
#pragma unroll
                for (int bj = 0; bj < 2; ++bj) { const size_t o = off + bj * HALF; f32x4 b0, b1;
                    if (base_f32) { b0 = *(const f32x4*)((const float*)base + o); b1 = *(const f32x4*)((const float*)base + o + 4); }
                    else { const u32x4 w = *(const u32x4*)((const bf16_t*)base + o); b0 = (f32x4){lo2f(w.x), hi2f(w.x), lo2f(w.y), hi2f(w.y)}; b1 = (f32x4){lo2f(w.z), hi2f(w.z), lo2f(w.w), hi2f(w.w)}; }
                    const f32x4 v0 = acc[ai][bj][m][0] + b0, v1 = acc[ai][bj][m][1] + b1;
                    u32x4 w; w.x = pack2(v0[0], v0[1]); w.y = pack2(v0[2], v0[3]); w.z = pack2(v1[0], v1[1]); w.w = pack2(v1[2], v1[3]);
                    *(u32x4*)(out + o) = w; } }
    }
};
struct EpiScaleRows {
    static constexpr bool PERM = true;
    bf16_t* out; int ldc; const float* roww;
    DI void operator()(const Acc& acc, const Unit& u, int wr, int wc, int fr, int fq) const {
        const int row0 = u.pm * BM + wr * 64 + fr, col0 = u.pn * BM + wc * 32 + 8 * fq;
#pragma unroll
        for (int ai = 0; ai < 2; ++ai)
#pragma unroll
            for (int m = 0; m < 4; ++m) { const int row = row0 + ai * HALF + m * 16; const float sw = roww[row]; const size_t off = (size_t)row * ldc + col0;
#pragma unroll
                for (int bj = 0; bj < 2; ++bj) { const f32x4 v0 = acc[ai][bj][m][0] * sw, v1 = acc[ai][bj][m][1] * sw;
                    u32x4 w; w.x = pack2(v0[0], v0[1]); w.y = pack2(v0[2], v0[3]); w.z = pack2(v1[0], v1[1]); w.w = pack2(v1[2], v1[3]);
                    *(u32x4*)(out + off + bj * HALF) = w; } }
    }
};
struct EpiSplit {
    static constexpr bool PERM = true;
    bf16_t* O; int ldc; int split_cols; size_t split_stride;
    DI void operator()(const Acc& acc, const Unit& u, int wr, int wc, int fr, int fq) const {
        const int row0 = u.pm * BM + wr * 64 + fr; int colt = u.pn * BM; bf16_t* base = O;
        { const int t = colt / split_cols; base += (size_t)t * split_stride; colt -= t * split_cols; }
        const int col0 = colt + wc * 32 + 8 * fq;
#pragma unroll
        for (int ai = 0; ai < 2; ++ai)
#pragma unroll
            for (int m = 0; m < 4; ++m) { bf16_t* rowp = base + (size_t)(row0 + ai * HALF + m * 16) * ldc + col0;
#pragma unroll
                for (int bj = 0; bj < 2; ++bj) { const f32x4 v0 = acc[ai][bj][m][0], v1 = acc[ai][bj][m][1];
                    u32x4 w; w.x = pack2(v0[0], v0[1]); w.y = pack2(v0[2], v0[3]); w.z = pack2(v1[0], v1[1]); w.w = pack2(v1[2], v1[3]);
                    *(u32x4*)(rowp + bj * HALF) = w; } }
    }
};
struct EpiSwiglu {
    static constexpr bool PERM = true;
    bf16_t* O; int ldc;
    DI void operator()(const Acc& acc, const Unit& u, int wr, int wc, int fr, int fq) const {
        const int row0 = u.pm * BM + wr * 64 + fr, col0 = u.pn * HALF + wc * 32 + 8 * fq;
#pragma unroll
        for (int ai = 0; ai < 2; ++ai)
#pragma unroll
            for (int m = 0; m < 4; ++m) { bf16_t* rowp = O + (size_t)(row0 + ai * HALF + m * 16) * ldc + col0;
                float r[8];
#pragma unroll
                for (int n = 0; n < 2; ++n)
#pragma unroll
                    for (int j = 0; j < 4; ++j) { const float g = acc[ai][0][m][n][j], uu = acc[ai][1][m][n][j]; r[n * 4 + j] = silu_f(g) * uu; }
                u32x4 w; w.x = pack2(r[0], r[1]); w.y = pack2(r[2], r[3]); w.z = pack2(r[4], r[5]); w.w = pack2(r[6], r[7]);
                *(u32x4*)rowp = w; }
    }
};
struct EpiMoe {
    static constexpr bool PERM = true;
    bf16_t* act; bf16_t* y; const float* roww;
    DI void operator()(const Acc& acc, const Unit& u, int wr, int wc, int fr, int fq) const {
        if (u.aux & 256) { EpiScaleRows E{y, 2048, roww}; E(acc, u, wr, wc, fr, fq); }
        else { EpiSwiglu E{act, 2048}; E(acc, u, wr, wc, fr, fq); }
    }
};
struct EpiHeads {
    static constexpr bool PERM = true;
    bf16_t* O; int hpt; size_t tstride; unsigned rope_mask; bf16_t* O2; const float* ctab; const float* stab;
    DI void operator()(const Acc& acc, const Unit& u, int wr, int wc, int fr, int fq) const {
        const int row0 = u.pm * BM + wr * 64 + fr, d0 = wc * 32 + 8 * fq;
#pragma unroll
        for (int bj = 0; bj < 2; ++bj) { const int c128 = u.pn * 2 + bj, t = c128 / hpt, hd = c128 - t * hpt; bf16_t* tb = O + (size_t)t * tstride;
            const bool rot = ((rope_mask >> t) & 1u) != 0u;
#pragma unroll
            for (int ai = 0; ai < 2; ++ai)
#pragma unroll
                for (int m = 0; m < 4; ++m) { const int row = row0 + ai * HALF + m * 16, b = row >> 11, s = row & 2047;
                    const size_t po = ((size_t)(b * hpt + hd) * 2048 + s) * 128 + d0; const f32x4 v0 = acc[ai][bj][m][0], v1 = acc[ai][bj][m][1];
                    u32x4 w; w.x = pack2(v0[0], v0[1]); w.y = pack2(v0[2], v0[3]); w.z = pack2(v1[0], v1[1]); w.w = pack2(v1[2], v1[3]);
                    u32x4 wr_ = w;
                    if (rot && wc == 0) {
                        const int j0 = 8 * (fq & 1); const float sgn = (fq & 2) ? 1.f : -1.f;
                        const f32x4 ca = *(const f32x4*)(ctab + (size_t)row * 16 + j0), cb = *(const f32x4*)(ctab + (size_t)row * 16 + j0 + 4);
                        const f32x4 sa = *(const f32x4*)(stab + (size_t)row * 16 + j0), sb = *(const f32x4*)(stab + (size_t)row * 16 + j0 + 4);
                        float o[8];
#pragma unroll
                        for (int e = 0; e < 4; ++e) {
                            const float pa = xor_f<32>(v0[e]), pb = xor_f<32>(v1[e]);
                            o[e] = v0[e] * ca[e] + sgn * pa * sa[e]; o[4 + e] = v1[e] * cb[e] + sgn * pb * sb[e]; }
                        wr_.x = pack2(o[0], o[1]); wr_.y = pack2(o[2], o[3]); wr_.z = pack2(o[4], o[5]); wr_.w = pack2(o[6], o[7]);
                    }
                    if (O2) { *(u32x4*)(tb + po) = w; *(u32x4*)(O2 + po) = wr_; } else *(u32x4*)(tb + po) = wr_; } }
    }
};
struct EpiCmp {
    static constexpr bool PERM = false;
    float* part;
    DI void operator()(const Acc& acc, const Unit& u, int wr, int wc, int fr, int fq) const {
        float* O = part + (size_t)u.aux * 4096 * 512;
        const int row0 = u.pm * BM + wr * 64 + fr, col0 = u.pn * BM + wc * 32 + 4 * fq;
#pragma unroll
        for (int ai = 0; ai < 2; ++ai)
#pragma unroll
            for (int m = 0; m < 4; ++m) { const size_t off = (size_t)(row0 + ai * HALF + m * 16) * 512 + col0;
#pragma unroll
                for (int bj = 0; bj < 2; ++bj)
#pragma unroll
                    for (int n = 0; n < 2; ++n) *(f32x4*)(O + off + bj * HALF + n * 16) = acc[ai][bj][m][n]; }
    }
};

template <class Epi, class Sched, bool GA = false>
DI void gemm_phase(LAS unsigned char* lds, const Gemm g, const Sched& S, const Epi& E, int tid_in) {
    int tid_ = tid_in; asm volatile("" : "+v"(tid_));
    const int tid = tid_, wid = __builtin_amdgcn_readfirstlane(tid >> 6), lane = tid & 63, wr = wid >> 2, wc = wid & 3, fr = lane & 15, fq = lane >> 4;
    const int K = g.K, nt = K / BK;
    unsigned voffA[2], voffB[2];
#pragma unroll
    for (int i = 0; i < 2; ++i) { int R, C; stage_rc(tid * 16 + i * 8192, R, C); const int Rb = Epi::PERM ? ((R & ~31) + perm32(R & 31)) : R;
        voffA[i] = (unsigned)(R * g.lda + C) * 2u; voffB[i] = (unsigned)(Rb * g.ldb + C) * 2u; }
    const size_t kstep = (size_t)(BK * 2);
    const size_t hstepA = (size_t)HALF * g.lda * 2, hstepB = (size_t)HALF * g.ldb * 2;
    const unsigned ldsw = (unsigned)wid * 1024u;
    const int aoff = lds_byte(wr * 64 + fr, fq * 8), boff = lds_byte(wc * 32 + fr, fq * 8);
#define PG8_SA(b, h) (((b) * 2 + (h)) * HTB)
#define PG8_SB(b, h) ((4 + (b) * 2 + (h)) * HTB)
#define PG8_STAGE(bufoff, gbase, voff) do { _Pragma("unroll") for (int _i = 0; _i < 2; ++_i) \
        __builtin_amdgcn_global_load_lds((const unsigned*)((const char*)(gbase) + (voff)[_i]), (LAS unsigned*)(lds + (bufoff) + ldsw + _i * 8192), 16, 0, 0); } while (0)
#define PG8_LDA(dst, b, h) do { _Pragma("unroll") for (int m = 0; m < 4; ++m) _Pragma("unroll") for (int k = 0; k < 2; ++k) dst[m][k] = *(const LAS bf16x8*)(lds + PG8_SA(b, h) + aoff + m * 2048 + k * 1024); } while (0)
#define PG8_LDB(dst, b, h) do { _Pragma("unroll") for (int n = 0; n < 2; ++n) _Pragma("unroll") for (int k = 0; k < 2; ++k) dst[n][k] = *(const LAS bf16x8*)(lds + PG8_SB(b, h) + boff + n * 2048 + k * 1024); } while (0)
#define PG8_MMA(ai, bj, At, Bt) do { __builtin_amdgcn_s_setprio(1); _Pragma("unroll") for (int m = 0; m < 4; ++m) _Pragma("unroll") for (int n = 0; n < 2; ++n) _Pragma("unroll") for (int k = 0; k < 2; ++k) \
        acc[ai][bj][m][n] = __builtin_amdgcn_mfma_f32_16x16x32_bf16(Bt[n][k], At[m][k], acc[ai][bj][m][n], 0, 0, 0); __builtin_amdgcn_s_setprio(0); } while (0)
#define PG8_WAIT_V(n) asm volatile("s_waitcnt vmcnt(" #n ")" ::: "memory")
#define PG8_WAIT_L(n) asm volatile("s_waitcnt lgkmcnt(" #n ")" ::: "memory")
#define PG8_BAR __builtin_amdgcn_s_barrier()
#define PG8_SCHED __builtin_amdgcn_sched_barrier(0)
    Unit cur, nxt; int ui = 0;
    if (!S.next(0, cur)) return;
    unsigned gA[2][2], gN[2][2];
    if constexpr (GA) {
#pragma unroll
        for (int i = 0; i < 2; ++i) { int R, C; stage_rc(tid * 16 + i * 8192, R, C); gA[0][i] = S.a_off(cur, R, C); gA[1][i] = S.a_off(cur, HALF + R, C); } }
    f32x4 acc[2][2][4][2];
#pragma unroll
    for (int a = 0; a < 2; ++a)
#pragma unroll
        for (int b = 0; b < 2; ++b)
#pragma unroll
            for (int m = 0; m < 4; ++m)
#pragma unroll
                for (int n = 0; n < 2; ++n) acc[a][b][m][n] = (f32x4){0.f, 0.f, 0.f, 0.f};
    bf16x8 At[4][2], B0[2][2], B1[2][2];
    const char* cA = cur.A; const char* cB = cur.B;
    S.a_ready(cur);
#define PG8_STAGE_A(bufoff, gp, h, gv) do { if constexpr (GA) PG8_STAGE(bufoff, gp, gv); else PG8_STAGE(bufoff, (gp) + ((h) ? hstepA : (size_t)0), voffA); } while (0)
    PG8_STAGE(PG8_SB(0, 0), cB, voffB); PG8_STAGE_A(PG8_SA(0, 0), cA, 0, gA[0]); PG8_STAGE(PG8_SB(0, 1), cB + hstepB, voffB); PG8_STAGE_A(PG8_SA(0, 1), cA, 1, gA[1]);
    if (wr == 1) PG8_BAR;
    PG8_WAIT_V(4); PG8_BAR;
    PG8_STAGE(PG8_SB(1, 0), cB + kstep, voffB); PG8_STAGE_A(PG8_SA(1, 0), cA + kstep, 0, gA[0]); PG8_STAGE(PG8_SB(1, 1), cB + hstepB + kstep, voffB);
    PG8_WAIT_V(6); PG8_BAR;
    for (;;) {
        const bool has_next = S.next(ui + 1, nxt);
        const char* nA = has_next ? nxt.A : cA; const char* nB = has_next ? nxt.B : cB;
        if constexpr (GA) {
#pragma unroll
            for (int i = 0; i < 2; ++i) { int R, C; stage_rc(tid * 16 + i * 8192, R, C);
                gN[0][i] = has_next ? S.a_off(nxt, R, C) : gA[0][i]; gN[1][i] = has_next ? S.a_off(nxt, HALF + R, C) : gA[1][i]; } }
        for (int t = 0; t < nt; t += 2) {
            const bool last = (t == nt - 2);
            unsigned va[2][2];
            if constexpr (GA) {
#pragma unroll
                for (int h = 0; h < 2; ++h)
#pragma unroll
                    for (int i = 0; i < 2; ++i) va[h][i] = last ? gN[h][i] : gA[h][i]; }
            const char* a1 = cA + (size_t)(t + 1) * kstep;
            const char* a2 = last ? nA : cA + (size_t)(t + 2) * kstep; const char* b2 = last ? nB : cB + (size_t)(t + 2) * kstep;
            const char* a3 = a2 + kstep; const char* b3 = b2 + kstep;
            if (last && has_next) S.a_ready(nxt);
            PG8_LDB(B0, 0, 0); PG8_SCHED; PG8_LDA(At, 0, 0); PG8_STAGE_A(PG8_SA(1, 1), a1, 1, gA[1]);
            PG8_WAIT_L(8); PG8_BAR; PG8_WAIT_L(0); PG8_MMA(0, 0, At, B0); PG8_BAR; PG8_SCHED;
            PG8_LDB(B1, 0, 1); PG8_STAGE(PG8_SB(0, 0), b2, voffB);
            PG8_BAR; PG8_WAIT_L(0); PG8_MMA(0, 1, At, B1); PG8_BAR;
            PG8_LDA(At, 0, 1); PG8_STAGE_A(PG8_SA(0, 0), a2, 0, va[0]);
            PG8_BAR; PG8_WAIT_L(0); PG8_MMA(1, 0, At, B0); PG8_BAR; PG8_SCHED;
            PG8_STAGE(PG8_SB(0, 1), b2 + hstepB, voffB);
            PG8_WAIT_V(6); PG8_BAR; PG8_MMA(1, 1, At, B1); PG8_BAR;
            PG8_LDB(B0, 1, 0); PG8_SCHED; PG8_LDA(At, 1, 0); PG8_STAGE_A(PG8_SA(0, 1), a2, 1, va[1]);
            PG8_WAIT_L(8); PG8_BAR; PG8_WAIT_L(0); PG8_MMA(0, 0, At, B0); PG8_BAR; PG8_SCHED;
            PG8_LDB(B1, 1, 1); PG8_STAGE(PG8_SB(1, 0), b3, voffB);
            PG8_BAR; PG8_WAIT_L(0); PG8_MMA(0, 1, At, B1); PG8_BAR;
            PG8_LDA(At, 1, 1); PG8_STAGE_A(PG8_SA(1, 0), a3, 0, va[0]);
            PG8_BAR; PG8_WAIT_L(0); PG8_MMA(1, 0, At, B0); PG8_BAR; PG8_SCHED;
            PG8_STAGE(PG8_SB(1, 1), b3 + hstepB, voffB);
            PG8_WAIT_V(6); PG8_BAR; PG8_MMA(1, 1, At, B1); PG8_BAR;
        }
        E(acc, cur, wr, wc, fr, fq); S.done(cur);
        if (!has_next) break;
#pragma unroll
        for (int a = 0; a < 2; ++a)
#pragma unroll
            for (int b = 0; b < 2; ++b)
#pragma unroll
                for (int m = 0; m < 4; ++m)
#pragma unroll
                    for (int n = 0; n < 2; ++n) acc[a][b][m][n] = (f32x4){0.f, 0.f, 0.f, 0.f};
        cur = nxt; cA = nA; cB = nB; ++ui;
        if constexpr (GA) { gA[0][0] = gN[0][0]; gA[0][1] = gN[0][1]; gA[1][0] = gN[1][0]; gA[1][1] = gN[1][1]; }
    }
    PG8_WAIT_V(0);
    if (wr == 0) PG8_BAR;
    PG8_BAR;
#undef PG8_SA
#undef PG8_SB
#undef PG8_STAGE
#undef PG8_STAGE_A
#undef PG8_LDA
#undef PG8_LDB
#undef PG8_MMA
#undef PG8_WAIT_V
#undef PG8_WAIT_L
#undef PG8_BAR
#undef PG8_SCHED
}
}

struct Params {
    const float* in[28];
    float* out;
    unsigned char* ws;
    int ph_lo, ph_hi;
};
enum { I_X = 0, I_POS, I_ATTN_NORM, I_FFN_NORM, I_FINAL_NORM, I_GDN_W_IN, I_GDN_CONV, I_GDN_A_LOG, I_GDN_DT_BIAS, I_GDN_OUT_NORM, I_GDN_W_OUT, I_KV_NORM, I_NSA_W_KV,
       I_CMP_POS_K, I_CMP_W1_K, I_CMP_W2_K, I_CMP_POS_V, I_CMP_W1_V, I_CMP_W2_V, I_NSA_W_Q, I_NSA_W_O, I_FFN_W_GATE, I_FFN_W_UP, I_FFN_W_DOWN, I_MOE_ROUTER, I_MOE_W_GATE, I_MOE_W_UP, I_MOE_W_DOWN };

struct Ctx {
    unsigned char* lds; int tid, lane, wid, G, bid;
};

DI void cvt_task(const Ctx& c, int& tbase, const float* src, int ld, int K, int N, int Npad, bf16_t* dst, int mode) {
    const int ntn = Npad / 64, ntiles = (K / 256) * ntn;
    unsigned* T = (unsigned*)c.lds;
    int t = (c.bid - (tbase % c.G) + c.G) % c.G;
    for (; t < ntiles; t += c.G) {
        const int kt = t / ntn, nt = t - kt * ntn, k0 = kt * 256, n0 = nt * 64;
        const int n4 = c.tid & 15, kp = c.tid >> 4, n = n0 + 4 * n4;
        f32x4 a[4], b[4];
#pragma unroll
        for (int it = 0; it < 4; ++it) {
            const int k = k0 + 2 * (kp + 32 * it);
            a[it] = (f32x4){0.f, 0.f, 0.f, 0.f}; b[it] = a[it];
            if (n < N) { a[it] = *(const f32x4*)(src + (size_t)k * ld + n); b[it] = *(const f32x4*)(src + (size_t)(k + 1) * ld + n); }
        }
#pragma unroll
        for (int it = 0; it < 4; ++it)
#pragma unroll
            for (int i = 0; i < 4; ++i) T[(4 * n4 + i) * 129 + kp + 32 * it] = pack2(a[it][i], b[it][i]);
        __syncthreads();
        int rbase = n0;
        if (mode) rbase = (n0 >> 7) * 256 + (n0 & 127) + (mode == 2 ? 128 : 0);
#pragma unroll
        for (int j = 0; j < 4; ++j) {
            const int ch = c.tid + 512 * j, row = ch >> 5, cc = ch & 31;
            u32x4 w; w.x = T[row * 129 + 4 * cc]; w.y = T[row * 129 + 4 * cc + 1]; w.z = T[row * 129 + 4 * cc + 2]; w.w = T[row * 129 + 4 * cc + 3];
            *(u32x4*)(dst + (size_t)(rbase + row) * K + k0 + 8 * cc) = w;
        }
        __syncthreads();
    }
    tbase += ntiles;
}

template <bool SRC_F32, int RB>
DI void norm_phase(const Ctx& c, const void* src, const bf16_t* y, const int* slot_of, bf16_t* hwb, const float* w1, bf16_t* out1, const float* w2, bf16_t* out2, float* outf) {
    for (int chunk = c.bid; chunk < M_TOK / 64; chunk += c.G)
#pragma unroll 1
    for (int kk = 0; kk < 8; kk += RB) {
        const int row0 = chunk * 64 + c.wid * 8 + kk;
        float x[RB][4][8];
        if constexpr (SRC_F32) {
#pragma unroll
            for (int r = 0; r < RB; ++r) { const float* p = (const float*)src + (size_t)(row0 + r) * DM;
#pragma unroll
                for (int i = 0; i < 4; ++i) { const f32x4 a = *(const f32x4*)(p + 8 * (c.lane + 64 * i)), b = *(const f32x4*)(p + 8 * (c.lane + 64 * i) + 4);
                    x[r][i][0] = a[0]; x[r][i][1] = a[1]; x[r][i][2] = a[2]; x[r][i][3] = a[3]; x[r][i][4] = b[0]; x[r][i][5] = b[1]; x[r][i][6] = b[2]; x[r][i][7] = b[3]; } }
        } else {
            u32x4 raw[RB][4];
#pragma unroll
            for (int r = 0; r < RB; ++r) { const bf16_t* p = (const bf16_t*)src + (size_t)(row0 + r) * DM;
#pragma unroll
                for (int i = 0; i < 4; ++i) raw[r][i] = *(const u32x4*)(p + 8 * (c.lane + 64 * i)); }
#pragma unroll
            for (int r = 0; r < RB; ++r)
#pragma unroll
                for (int i = 0; i < 4; ++i) { const u32x4 w = raw[r][i];
                    x[r][i][0] = lo2f(w.x); x[r][i][1] = hi2f(w.x); x[r][i][2] = lo2f(w.y); x[r][i][3] = hi2f(w.y); x[r][i][4] = lo2f(w.z); x[r][i][5] = hi2f(w.z); x[r][i][6] = lo2f(w.w); x[r][i][7] = hi2f(w.w); }
        }
        if (y) {
            int s0[RB], s1[RB];
#pragma unroll
            for (int r = 0; r < RB; ++r) { s0[r] = slot_of[(row0 + r) * 2]; s1[r] = slot_of[(row0 + r) * 2 + 1]; }
#pragma unroll
            for (int r = 0; r < RB; ++r) {
                const bf16_t* y0 = y + (size_t)s0[r] * DM; const bf16_t* y1 = y + (size_t)s1[r] * DM;
#pragma unroll
                for (int i = 0; i < 4; ++i) { const u32x4 a = *(const u32x4*)(y0 + 8 * (c.lane + 64 * i)), b = *(const u32x4*)(y1 + 8 * (c.lane + 64 * i));
                    x[r][i][0] += lo2f(a.x) + lo2f(b.x); x[r][i][1] += hi2f(a.x) + hi2f(b.x); x[r][i][2] += lo2f(a.y) + lo2f(b.y); x[r][i][3] += hi2f(a.y) + hi2f(b.y);
                    x[r][i][4] += lo2f(a.z) + lo2f(b.z); x[r][i][5] += hi2f(a.z) + hi2f(b.z); x[r][i][6] += lo2f(a.w) + lo2f(b.w); x[r][i][7] += hi2f(a.w) + hi2f(b.w); }
                if (hwb) {
#pragma unroll
                    for (int i = 0; i < 4; ++i) { u32x4 w; w.x = pack2(x[r][i][0], x[r][i][1]); w.y = pack2(x[r][i][2], x[r][i][3]); w.z = pack2(x[r][i][4], x[r][i][5]); w.w = pack2(x[r][i][6], x[r][i][7]);
                        *(u32x4*)(hwb + (size_t)(row0 + r) * DM + 8 * (c.lane + 64 * i)) = w;
                        x[r][i][0] = lo2f(w.x); x[r][i][1] = hi2f(w.x); x[r][i][2] = lo2f(w.y); x[r][i][3] = hi2f(w.y); x[r][i][4] = lo2f(w.z); x[r][i][5] = hi2f(w.z); x[r][i][6] = lo2f(w.w); x[r][i][7] = hi2f(w.w); }
                }
            }
        }
        float rs[RB];
#pragma unroll
        for (int r = 0; r < RB; ++r) { float ss = 0.f;
#pragma unroll
            for (int i = 0; i < 4; ++i)
#pragma unroll
                for (int e = 0; e < 8; ++e) ss += x[r][i][e] * x[r][i][e];
            rs[r] = ss; }
#pragma unroll
        for (int r = 0; r < RB; ++r) rs[r] = rsqrtf(wave_sum(rs[r]) * (1.0f / DM) + NORM_EPS);
#pragma unroll
        for (int i = 0; i < 4; ++i) {
            const int col = 8 * (c.lane + 64 * i);
            const f32x4 wa = *(const f32x4*)(w1 + col), wb = *(const f32x4*)(w1 + col + 4);
            f32x4 va = wa, vb = wb;
            if (out2) { va = *(const f32x4*)(w2 + col); vb = *(const f32x4*)(w2 + col + 4); }
#pragma unroll
            for (int r = 0; r < RB; ++r) {
                const size_t ro = (size_t)(row0 + r) * DM + col;
                float o[8];
#pragma unroll
                for (int e = 0; e < 4; ++e) { o[e] = x[r][i][e] * rs[r] * wa[e]; o[4 + e] = x[r][i][4 + e] * rs[r] * wb[e]; }
                if (outf) { *(f32x4*)(outf + ro) = (f32x4){o[0], o[1], o[2], o[3]}; *(f32x4*)(outf + ro + 4) = (f32x4){o[4], o[5], o[6], o[7]}; }
                else { u32x4 w; w.x = pack2(o[0], o[1]); w.y = pack2(o[2], o[3]); w.z = pack2(o[4], o[5]); w.w = pack2(o[6], o[7]); *(u32x4*)(out1 + ro) = w; }
                if (out2) { u32x4 w;
                    w.x = pack2(x[r][i][0] * rs[r] * va[0], x[r][i][1] * rs[r] * va[1]); w.y = pack2(x[r][i][2] * rs[r] * va[2], x[r][i][3] * rs[r] * va[3]);
                    w.z = pack2(x[r][i][4] * rs[r] * vb[0], x[r][i][5] * rs[r] * vb[1]); w.w = pack2(x[r][i][6] * rs[r] * vb[2], x[r][i][7] * rs[r] * vb[3]);
                    *(u32x4*)(out2 + ro) = w; }
            }
        }
    }
}

template <int NT>
DI void skinny_phase(const Ctx& c, const bf16_t* A, const bf16_t* Wt, float* out, int ldo, int NS) {
    float* red = (float*)c.lds;
    for (int chunk = c.bid; chunk < M_TOK / 64; chunk += c.G) {
        const int lane = lane_id(), m = lane & 15, g = lane >> 4;
        const int r0 = chunk * 64, k0 = 256 * c.wid;
        const bf16_t* ap = A + (size_t)(r0 + m) * DM + k0 + 8 * g;
        const bf16_t* bp = Wt + (size_t)m * DM + k0 + 8 * g;
        f32x4 acc[4][NT];
#pragma unroll
        for (int mt = 0; mt < 4; ++mt)
#pragma unroll
            for (int nt = 0; nt < NT; ++nt) acc[mt][nt] = (f32x4){0.f, 0.f, 0.f, 0.f};
#pragma unroll
        for (int bt = 0; bt < 4; ++bt) {
            bf16x8 af[2][4], bfr[2][NT];
#pragma unroll
            for (int s = 0; s < 2; ++s) {
#pragma unroll
                for (int mt = 0; mt < 4; ++mt) af[s][mt] = *(const bf16x8*)(ap + (size_t)(16 * mt) * DM + 32 * (2 * bt + s));
#pragma unroll
                for (int nt = 0; nt < NT; ++nt) bfr[s][nt] = *(const bf16x8*)(bp + (size_t)(16 * nt) * DM + 32 * (2 * bt + s));
            }
#pragma unroll
            for (int s = 0; s < 2; ++s)
#pragma unroll
                for (int mt = 0; mt < 4; ++mt)
#pragma unroll
                    for (int nt = 0; nt < NT; ++nt) acc[mt][nt] = MFMA16(af[s][mt], bfr[s][nt], acc[mt][nt]);
        }
        __syncthreads();
#pragma unroll
        for (int mt = 0; mt < 4; ++mt)
#pragma unroll
            for (int nt = 0; nt < NT; ++nt) *(f32x4*)(red + ((size_t)((c.wid * 4 + mt) * NT + nt) * 64 + lane) * 4) = acc[mt][nt];
        __syncthreads();
        for (int o = c.tid; o < 64 * 16 * NT; o += NTHREADS) {
            const int col = o % (16 * NT), row = o / (16 * NT), mt = row >> 4, gg = (row >> 2) & 3, r = row & 3, nt = col >> 4, mm = col & 15;
            float sum = 0.f;
#pragma unroll
            for (int w = 0; w < 8; ++w) sum += red[((size_t)((w * 4 + mt) * NT + nt) * 64 + 16 * gg + mm) * 4 + r];
            if (col < NS) out[(size_t)(r0 + row) * ldo + col] = sum;
        }
    }
}

DI void rope_table_phase(const Ctx& c, const int* pos, float* ctab, float* stab) {
    for (int i = c.bid * NTHREADS + c.tid; i < M_TOK * 16; i += c.G * NTHREADS) {
        const int tok = i >> 4, j = i & 15;
        const float inv = exp2f(-(float)j * (18.931568569324174f / 16.0f));
        const float ang = (float)pos[tok] * inv;
        float rev = ang * 0.15915494309189535f; rev -= floorf(rev);
        ctab[i] = __builtin_amdgcn_cosf(rev); stab[i] = __builtin_amdgcn_sinf(rev);
    }
}
DI void cmp_bias_phase(const Ctx& c, const float* posk, const float* w1k, const float* posv, const float* w1v, float* part) {
    for (int sl = c.bid; sl < 256; sl += c.G) {
        const int pr = sl & 1, j = sl >> 1; const float* pos = pr ? posv : posk; const float* w1 = pr ? w1v : w1k;
        float sm = 0.f;
#pragma unroll 8
        for (int k = 32 * j; k < 32 * j + 32; ++k) sm += pos[k] * w1[(size_t)k * 512 + c.tid];
        part[(size_t)(pr * 128 + j) * 512 + c.tid] = sm;
    }
}
DI void cmp_bias_reduce(const Ctx& c, const float* part, float* bk, float* bv) {
    if (c.bid < 2) { float sm = 0.f;
        for (int j = 0; j < 128; ++j) sm += part[(size_t)(c.bid * 128 + j) * 512 + c.tid];
        (c.bid ? bv : bk)[c.tid] = sm; }
}

template <int CTRL> DI float dpp_mov(float v) { return __uint_as_float((unsigned)__builtin_amdgcn_update_dpp(0, (int)__float_as_uint(v), CTRL, 0xf, 0xf, true)); }
DI float wave_sum_dpp(float v) {
    v += dpp_mov<0xB1>(v);
    v += dpp_mov<0x4E>(v);
    v += dpp_mov<0x141>(v);
    v += dpp_mov<0x140>(v);
    const int u = (int)__float_as_uint(v);
    return (__uint_as_float((unsigned)__builtin_amdgcn_readlane(u, 0)) + __uint_as_float((unsigned)__builtin_amdgcn_readlane(u, 16)))
         + (__uint_as_float((unsigned)__builtin_amdgcn_readlane(u, 32)) + __uint_as_float((unsigned)__builtin_amdgcn_readlane(u, 48)));
}
DI void gdn_conv2_phase(const Ctx& c, const bf16_t* Pq, const bf16_t* Pk, const bf16_t* Pv, const float* convw, const float* ba,
                        const float* a_log, const float* dt_bias, bf16_t* Qn, bf16_t* Kn, bf16_t* KT, bf16_t* VT, float* Gc, float* Bb) {
    const int gw = c.bid * NWAVES + c.wid, GW = c.G * NWAVES;
    for (int u = gw; u < NB * 16 * 32; u += GW) {
        const int lane = lane_id();
        const int n = u & 31, h = (u >> 5) & 15, b = u >> 9;
        const int tok0 = b * SEQ + 64 * n;
        {
            const int tok = tok0 + lane;
            const float bl = ba[(size_t)tok * 32 + h], av = ba[(size_t)tok * 32 + 16 + h] + dt_bias[h];
            const float sp = fmaxf(av, 0.f) + log1pf(__expf(-fabsf(av)));
            float g = -__expf(a_log[h]) * sp;
#pragma unroll
            for (int o = 1; o < 64; o <<= 1) { const float t = __uint_as_float((unsigned)__builtin_amdgcn_ds_bpermute(((lane - o) & 63) << 2, (int)__float_as_uint(g))); if (lane >= o) g += t; }
            Gc[(size_t)tok * 16 + h] = g; Bb[(size_t)tok * 16 + h] = fast_sigmoid(bl);
        }
        const int col = h * 128 + 2 * lane;
        float wq[4][2], wk[4][2], wv[4][2];
#pragma unroll
        for (int j = 0; j < 4; ++j) { const float* w = convw + (size_t)j * 6144 + col; wq[j][0] = w[0]; wq[j][1] = w[1]; wk[j][0] = w[2048]; wk[j][1] = w[2049]; wv[j][0] = w[4096]; wv[j][1] = w[4097]; }
        unsigned hq[3] = {0u, 0u, 0u}, hk[3] = {0u, 0u, 0u}, hv[3] = {0u, 0u, 0u};
#pragma unroll
        for (int i = 0; i < 3; ++i) { const int s = 64 * n - 3 + i;
            if (s >= 0) { const size_t off = (size_t)(b * SEQ + s) * DM + col; hq[i] = *(const unsigned*)(Pq + off); hk[i] = *(const unsigned*)(Pk + off); hv[i] = *(const unsigned*)(Pv + off); } }
        const size_t rowoff = (size_t)tok0 * DM + col;
        unsigned cq[8], ck[8], cv[8];
#pragma unroll
        for (int e = 0; e < 8; ++e) { const size_t off = rowoff + (size_t)e * DM; cq[e] = *(const unsigned*)(Pq + off); ck[e] = *(const unsigned*)(Pk + off); cv[e] = *(const unsigned*)(Pv + off); }
        bf16_t* kt0 = KT + (size_t)u * 8192 + (size_t)(2 * lane) * 8; bf16_t* vt0 = VT + (size_t)u * 8192 + (size_t)(2 * lane) * 8;
#pragma unroll
        for (int q8 = 0; q8 < 8; ++q8) {
            unsigned nq[8], nk[8], nv[8];
            if (q8 < 7) {
#pragma unroll
                for (int e = 0; e < 8; ++e) { const size_t off = rowoff + (size_t)(8 * (q8 + 1) + e) * DM; nq[e] = *(const unsigned*)(Pq + off); nk[e] = *(const unsigned*)(Pk + off); nv[e] = *(const unsigned*)(Pv + off); }
            }
            float q0[8], q1[8], k0[8], k1[8], v0[8], v1[8], sq[8], sk[8];
#pragma unroll
            for (int e = 0; e < 8; ++e) {
                const unsigned aq = (e >= 3) ? cq[e - 3] : hq[e], bq = (e >= 2) ? cq[e - 2] : hq[e + 1], cq_ = (e >= 1) ? cq[e - 1] : hq[e + 2], dq = cq[e];
                const unsigned ak = (e >= 3) ? ck[e - 3] : hk[e], bk = (e >= 2) ? ck[e - 2] : hk[e + 1], ck_ = (e >= 1) ? ck[e - 1] : hk[e + 2], dk = ck[e];
                const unsigned av = (e >= 3) ? cv[e - 3] : hv[e], bv = (e >= 2) ? cv[e - 2] : hv[e + 1], cv_ = (e >= 1) ? cv[e - 1] : hv[e + 2], dv = cv[e];
                float a0 = wq[0][0] * lo2f(aq) + wq[1][0] * lo2f(bq) + wq[2][0] * lo2f(cq_) + wq[3][0] * lo2f(dq);
                float a1 = wq[0][1] * hi2f(aq) + wq[1][1] * hi2f(bq) + wq[2][1] * hi2f(cq_) + wq[3][1] * hi2f(dq);
                float b0 = wk[0][0] * lo2f(ak) + wk[1][0] * lo2f(bk) + wk[2][0] * lo2f(ck_) + wk[3][0] * lo2f(dk);
                float b1 = wk[0][1] * hi2f(ak) + wk[1][1] * hi2f(bk) + wk[2][1] * hi2f(ck_) + wk[3][1] * hi2f(dk);
                float c0 = wv[0][0] * lo2f(av) + wv[1][0] * lo2f(bv) + wv[2][0] * lo2f(cv_) + wv[3][0] * lo2f(dv);
                float c1 = wv[0][1] * hi2f(av) + wv[1][1] * hi2f(bv) + wv[2][1] * hi2f(cv_) + wv[3][1] * hi2f(dv);
                q0[e] = silu_f(a0); q1[e] = silu_f(a1); k0[e] = silu_f(b0); k1[e] = silu_f(b1); v0[e] = silu_f(c0); v1[e] = silu_f(c1);
                sq[e] = q0[e] * q0[e] + q1[e] * q1[e]; sk[e] = k0[e] * k0[e] + k1[e] * k1[e];
            }
#pragma unroll
            for (int e = 0; e < 8; ++e) { sq[e] = wave_sum_dpp(sq[e]); sk[e] = wave_sum_dpp(sk[e]); }
#pragma unroll
            for (int e = 0; e < 8; ++e) {
                const float rq = rsqrtf(sq[e] + NORM_EPS) * 0.08838834764831845f, rk = rsqrtf(sk[e] + NORM_EPS);
                k0[e] *= rk; k1[e] *= rk;
                const size_t off = rowoff + (size_t)(8 * q8 + e) * DM;
                const size_t uo = (size_t)u * 8192 + (size_t)(8 * q8 + e) * 128 + 2 * lane;
                *(unsigned*)(Qn + uo) = pack2(q0[e] * rq, q1[e] * rq);
                *(unsigned*)(Kn + uo) = pack2(k0[e], k1[e]);
            }
            u32x4 w;
            w.x = pack2(k0[0], k0[1]); w.y = pack2(k0[2], k0[3]); w.z = pack2(k0[4], k0[5]); w.w = pack2(k0[6], k0[7]); *(u32x4*)(kt0 + 1024 * q8) = w;
            w.x = pack2(k1[0], k1[1]); w.y = pack2(k1[2], k1[3]); w.z = pack2(k1[4], k1[5]); w.w = pack2(k1[6], k1[7]); *(u32x4*)(kt0 + 1024 * q8 + 8) = w;
            w.x = pack2(v0[0], v0[1]); w.y = pack2(v0[2], v0[3]); w.z = pack2(v0[4], v0[5]); w.w = pack2(v0[6], v0[7]); *(u32x4*)(vt0 + 1024 * q8) = w;
            w.x = pack2(v1[0], v1[1]); w.y = pack2(v1[2], v1[3]); w.z = pack2(v1[4], v1[5]); w.w = pack2(v1[6], v1[7]); *(u32x4*)(vt0 + 1024 * q8 + 8) = w;
#pragma unroll
            for (int i = 0; i < 3; ++i) { hq[i] = cq[5 + i]; hk[i] = ck[5 + i]; hv[i] = cv[5 + i]; }
            if (q8 < 7) {
#pragma unroll
                for (int e = 0; e < 8; ++e) { cq[e] = nq[e]; ck[e] = nk[e]; cv[e] = nv[e]; }
            }
        }
    }
}

typedef float f32x16 __attribute__((ext_vector_type(16)));
DI int crow32(int r, int hi) { return (r & 3) + 8 * (r >> 2) + 4 * hi; }
DI bf16x8 pack8f(float a0, float a1, float a2, float a3, float a4, float a5, float a6, float a7) {
    u32x4 w; w.x = pack2(a0, a1); w.y = pack2(a2, a3); w.z = pack2(a4, a5); w.w = pack2(a6, a7); return __builtin_bit_cast(bf16x8, w); }

constexpr int SOLVE_LT_STRIDE = 68;
constexpr int SOLVE_WAVE_LDS = 64 * SOLVE_LT_STRIDE * 4 + 768;
DI void gdn_solve_phase(const Ctx& c, const bf16_t* Qn, const bf16_t* Kn, const bf16_t* KT, const bf16_t* VT, const float* Gc, const float* Bb,
                        bf16_t* UT, bf16_t* Wn, bf16_t* Aqk) {
    const int gw = c.bid * NWAVES + c.wid, GW = c.G * NWAVES;
    float* LT = (float*)(c.lds + c.wid * SOLVE_WAVE_LDS); float* gcl = LT + 64 * SOLVE_LT_STRIDE; float* bel = gcl + 64; float* egl = bel + 64;
    for (int u = gw; u < NB * 16 * 32; u += GW) {
        int lane_ = lane_id();
        const int lane = lane_, r32 = lane & 31, hi = lane >> 5;
        const int n = u & 31, h = (u >> 5) & 15, b = u >> 9;
        const int tok0 = b * SEQ + 64 * n;
        const float gc_l = Gc[(size_t)(tok0 + lane) * 16 + h], be_l = Bb[(size_t)(tok0 + lane) * 16 + h];
        gcl[lane] = gc_l; bel[lane] = be_l; egl[lane] = be_l * __expf(gc_l);
        bf16x8 kf[2][8];
#pragma unroll
        for (int t = 0; t < 2; ++t)
#pragma unroll
            for (int s = 0; s < 8; ++s) kf[t][s] = *(const bf16x8*)(Kn + (size_t)u * 8192 + (size_t)(32 * t + r32) * 128 + 16 * s + 8 * hi);
        __builtin_amdgcn_wave_barrier();
#pragma unroll
        for (int at = 0; at < 2; ++at)
#pragma unroll
            for (int bt = 0; bt <= at; ++bt) {
                f32x16 acc = {};
#pragma unroll
                for (int s = 0; s < 8; ++s) acc = MFMA32(kf[bt][s], kf[at][s], acc);
                const int a = 32 * at + r32; const float gca = gcl[a], bea = bel[a];
#pragma unroll
                for (int q = 0; q < 4; ++q) { const int b0 = 32 * bt + 8 * q + 4 * hi;
                    const f32x4 gb = *(const f32x4*)(gcl + b0); f32x4 o;
#pragma unroll
                    for (int e = 0; e < 4; ++e) o[e] = bea * acc[4 * q + e] * __expf(fminf(gca - gb[e], 0.f));
                    *(f32x4*)(LT + a * SOLVE_LT_STRIDE + b0) = o; }
            }
        bf16_t* aq = Aqk + (size_t)u * 4096;
#pragma unroll
        for (int it = 0; it < 2; ++it) {
            bf16x8 qf[8];
#pragma unroll
            for (int s = 0; s < 8; ++s) qf[s] = *(const bf16x8*)(Qn + (size_t)u * 8192 + (size_t)(32 * it + r32) * 128 + 16 * s + 8 * hi);
            const int i = 32 * it + r32; const float gci = gcl[i];
#pragma unroll
            for (int jt = 0; jt < 2; ++jt) {
                f32x16 acc = {};
                if (jt <= it) {
#pragma unroll
                    for (int s = 0; s < 8; ++s) acc = MFMA32(kf[jt][s], qf[s], acc);
                }
                const int lim = i - 32 * jt - 4 * hi;
#pragma unroll
                for (int q = 0; q < 4; ++q) { const int j0 = 32 * jt + 8 * q + 4 * hi; const f32x4 gj = *(const f32x4*)(gcl + j0); float o[4];
#pragma unroll
                    for (int e = 0; e < 4; ++e) o[e] = (8 * q + e <= lim) ? acc[4 * q + e] * __expf(fminf(gci - gj[e], 0.f)) : 0.f;
                    u32x2 w; w.x = pack2(o[0], o[1]); w.y = pack2(o[2], o[3]); *(u32x2*)(aq + (size_t)(j0 >> 2) * 256 + (size_t)i * 4) = w; }
            }
            asm volatile("" ::: "memory");
        }
        __builtin_amdgcn_wave_barrier();
        asm volatile("s_waitcnt lgkmcnt(0)" ::: "memory");
        float T[64];
#pragma unroll
        for (int cc = 0; cc < 64; ++cc) T[cc] = (lane == cc) ? 1.f : 0.f;
#pragma unroll
        for (int j = 63; j >= 1; --j) {
            const float tj = -T[j];
#pragma unroll
            for (int q = 0; q <= (j - 1) / 4; ++q) { const f32x4 lv = *(const f32x4*)(LT + j * SOLVE_LT_STRIDE + 4 * q);
#pragma unroll
                for (int e = 0; e < 4; ++e) { const int cc = 4 * q + e; if (cc < j) T[cc] = __builtin_fmaf(tj, lv[e], T[cc]); }
                if ((q & 7) == 7) asm volatile("" ::: "memory"); }
            asm volatile("" ::: "memory");
        }
        bf16x8 fb[2][4], fg[2][4];
#pragma unroll
        for (int s = 0; s < 4; ++s) {
            f32x4 bv[4], gv[4];
#pragma unroll
            for (int k = 0; k < 4; ++k) { bv[k] = *(const f32x4*)(bel + 16 * s + 4 * k); gv[k] = *(const f32x4*)(egl + 16 * s + 4 * k); }
            u32x4 f0, f1, g0v, g1v;
#pragma unroll
            for (int e = 0; e < 4; ++e) {
                const int j0 = 16 * s + 2 * e, j1 = j0 + 8, k0 = e >> 1, x0 = 2 * (e & 1);
                const unsigned pb0 = pack2(T[j0] * bv[k0][x0], T[j0 + 1] * bv[k0][x0 + 1]), pb1 = pack2(T[j1] * bv[2 + k0][x0], T[j1 + 1] * bv[2 + k0][x0 + 1]);
                const unsigned pg0 = pack2(T[j0] * gv[k0][x0], T[j0 + 1] * gv[k0][x0 + 1]), pg1 = pack2(T[j1] * gv[2 + k0][x0], T[j1 + 1] * gv[2 + k0][x0 + 1]);
                auto rb = __builtin_amdgcn_permlane32_swap(pb0, pb1, false, false); f0[e] = rb[0]; f1[e] = rb[1];
                auto rg = __builtin_amdgcn_permlane32_swap(pg0, pg1, false, false); g0v[e] = rg[0]; g1v[e] = rg[1];
            }
            fb[0][s] = __builtin_bit_cast(bf16x8, f0); fb[1][s] = __builtin_bit_cast(bf16x8, f1);
            fg[0][s] = __builtin_bit_cast(bf16x8, g0v); fg[1][s] = __builtin_bit_cast(bf16x8, g1v);
            asm volatile("" ::: "memory");
        }
        const bf16_t* vt = VT + (size_t)u * 8192; bf16_t* ut = UT + (size_t)u * 8192;
#pragma unroll
        for (int nt = 0; nt < 4; ++nt) {
            bf16x8 vf[4];
#pragma unroll
            for (int s = 0; s < 4; ++s) vf[s] = *(const bf16x8*)(vt + (size_t)(2 * s + hi) * 1024 + (size_t)(32 * nt + r32) * 8);
#pragma unroll
            for (int mt = 0; mt < 2; ++mt) {
                f32x16 acc = {};
#pragma unroll
                for (int s = 0; s < 4; ++s) acc = MFMA32(fb[mt][s], vf[s], acc);
#pragma unroll
                for (int q = 0; q < 4; ++q) { u32x2 w; w.x = pack2(acc[4 * q], acc[4 * q + 1]); w.y = pack2(acc[4 * q + 2], acc[4 * q + 3]);
                    *(u32x2*)(ut + (size_t)(8 * mt + 2 * q + hi) * 512 + (size_t)(32 * nt + r32) * 4) = w; }
            }
            asm volatile("" ::: "memory");
        }
        const bf16_t* kt = KT + (size_t)u * 8192; bf16_t* wn = Wn + (size_t)u * 8192;
#pragma unroll
        for (int dt = 0; dt < 4; ++dt) {
            bf16x8 kfr[4];
#pragma unroll
            for (int s = 0; s < 4; ++s) kfr[s] = *(const bf16x8*)(kt + (size_t)(2 * s + hi) * 1024 + (size_t)(32 * dt + r32) * 8);
#pragma unroll
            for (int it = 0; it < 2; ++it) {
                f32x16 acc = {};
#pragma unroll
                for (int s = 0; s < 4; ++s) acc = MFMA32(kfr[s], fg[it][s], acc);
#pragma unroll
                for (int q = 0; q < 4; ++q) { u32x2 w; w.x = pack2(-acc[4 * q], -acc[4 * q + 1]); w.y = pack2(-acc[4 * q + 2], -acc[4 * q + 3]);
                    *(u32x2*)(wn + (size_t)(8 * dt + 2 * q + hi) * 256 + (size_t)(32 * it + r32) * 4) = w; }
            }
            asm volatile("" ::: "memory");
        }
        __builtin_amdgcn_wave_barrier();
    }
}

constexpr int SC_W = 0, SC_Q = 17408, SC_K = 34816, SC_A = 53248, SC_U = 62464, SC_E = 71680, SC_BUF = 72320;
DI bf16x8 ld_frag8(const unsigned char* base, int off0, int off1) {
    const u32x2 a = *(const u32x2*)(base + off0), b = *(const u32x2*)(base + off1);
    u32x4 w; w.x = a.x; w.y = a.y; w.z = b.x; w.w = b.y; return __builtin_bit_cast(bf16x8, w);
}
#define LDS_BARRIER() do { asm volatile("s_waitcnt lgkmcnt(0)" ::: "memory"); __builtin_amdgcn_s_barrier(); asm volatile("" ::: "memory"); } while (0)
DI void gdn_scan_phase(const Ctx& c, const bf16_t* Qn, const bf16_t* KT, const bf16_t* UT, const bf16_t* Wn, const bf16_t* Aqk, const float* Gc, bf16_t* Og) {
    const bool loader = c.wid >= 4;
    for (int item = c.bid; item < NB * 16 * 2; item += c.G) {
        const int lane = lane_id(), lt = (c.wid - 4) * 64 + lane, m = lane & 15, g = lane >> 4;
        const int half = item & 1, h = (item >> 1) & 15, b = item >> 5;
        const int u0 = (b * 16 + h) * 32, col0 = half * 64 + 16 * c.wid;
        f32x4 S[8];
#pragma unroll
        for (int i = 0; i < 8; ++i) S[i] = (f32x4){0.f, 0.f, 0.f, 0.f};
        __syncthreads();
#define SC_P(x) ((((x) & ~7) | (((x) & 3) << 1) | (((x) >> 2) & 1)))
#define SC_LOAD(nn) do { const int u = u0 + (nn); const int tok0 = b * SEQ + 64 * (nn); \
            _Pragma("unroll") for (int k = 0; k < 4; ++k) { const int idx = lt + 256 * k, row = idx >> 4, cc = idx & 15; \
                st[k] = *(const u32x4*)(Wn + (size_t)u * 8192 + idx * 8);            \
                st[4 + k] = *(const u32x4*)(Qn + (size_t)u * 8192 + row * 128 + 8 * cc); } \
            _Pragma("unroll") for (int k = 0; k < 4; ++k) { const int idx = lt + 256 * k; st[8 + k] = *(const u32x4*)(KT + (size_t)u * 8192 + idx * 8); }   \
            _Pragma("unroll") for (int k = 0; k < 2; ++k) { const int idx = lt + 256 * k; st[12 + k] = *(const u32x4*)(Aqk + (size_t)u * 4096 + idx * 8); \
                st[14 + k] = *(const u32x4*)(UT + (size_t)u * 8192 + (size_t)(idx >> 5) * 512 + (size_t)half * 256 + (idx & 31) * 8); }     \
            if (lt < 64) { sg = Gc[(size_t)(tok0 + lt) * 16 + h]; sgl = Gc[(size_t)(tok0 + 63) * 16 + h]; } } while (0)
#define SC_WRITE(bufp) do { unsigned char* bb = (bufp); \
            _Pragma("unroll") for (int k = 0; k < 4; ++k) { const int idx = lt + 256 * k, row = idx >> 4, cc = idx & 15, gq = idx >> 5, pr = idx & 31; \
                *(u32x2*)(bb + SC_W + (2 * pr) * 272 + SC_P(gq) * 8) = (u32x2){st[k].x, st[k].y}; *(u32x2*)(bb + SC_W + (2 * pr + 1) * 272 + SC_P(gq) * 8) = (u32x2){st[k].z, st[k].w}; \
                *(u32x2*)(bb + SC_Q + row * 272 + SC_P(2 * cc) * 8) = (u32x2){st[4 + k].x, st[4 + k].y}; *(u32x2*)(bb + SC_Q + row * 272 + SC_P(2 * cc + 1) * 8) = (u32x2){st[4 + k].z, st[4 + k].w}; } \
            _Pragma("unroll") for (int k = 0; k < 4; ++k) { const int idx = lt + 256 * k, row = idx & 127, cc = idx >> 7; *(u32x2*)(bb + SC_K + row * 144 + SC_P(2 * cc) * 8) = (u32x2){st[8 + k].x, st[8 + k].y}; *(u32x2*)(bb + SC_K + row * 144 + SC_P(2 * cc + 1) * 8) = (u32x2){st[8 + k].z, st[8 + k].w}; } \
            _Pragma("unroll") for (int k = 0; k < 2; ++k) { const int idx = lt + 256 * k, gq = idx >> 5, pr = idx & 31; \
                *(u32x2*)(bb + SC_A + (2 * pr) * 144 + SC_P(gq) * 8) = (u32x2){st[12 + k].x, st[12 + k].y}; *(u32x2*)(bb + SC_A + (2 * pr + 1) * 144 + SC_P(gq) * 8) = (u32x2){st[12 + k].z, st[12 + k].w}; \
                *(u32x2*)(bb + SC_U + (2 * pr) * 144 + gq * 8) = (u32x2){st[14 + k].x, st[14 + k].y}; *(u32x2*)(bb + SC_U + (2 * pr + 1) * 144 + gq * 8) = (u32x2){st[14 + k].z, st[14 + k].w}; } \
            if (lt < 64) { float* ee = (float*)(bb + SC_E); ee[lt] = __expf(sg); ee[64 + lt] = __expf(sgl - sg); if (lt == 0) ee[128] = __expf(sgl); } } while (0)
        if (loader) {
            u32x4 stA[16], stB[16]; float sgA = 0.f, sglA = 0.f, sgB = 0.f, sglB = 0.f;
            { u32x4 st[16]; float sg = 0.f, sgl = 0.f; SC_LOAD(0); SC_WRITE(c.lds); }
            { u32x4 (&st)[16] = stA; float& sg = sgA; float& sgl = sglA; SC_LOAD(1); }
            LDS_BARRIER();
#pragma unroll 1
            for (int n = 0; n < 32; n += 2) {
                { u32x4 (&st)[16] = stB; float& sg = sgB; float& sgl = sglB; if (n + 2 < 32) SC_LOAD(n + 2); }
                { u32x4 (&st)[16] = stA; float& sg = sgA; float& sgl = sglA; SC_WRITE(c.lds + SC_BUF); }
                LDS_BARRIER();
                { u32x4 (&st)[16] = stA; float& sg = sgA; float& sgl = sglA; if (n + 3 < 32) SC_LOAD(n + 3); }
                { u32x4 (&st)[16] = stB; float& sg = sgB; float& sgl = sglB; if (n + 2 < 32) SC_WRITE(c.lds); }
                LDS_BARRIER();
            }
        } else {
            LDS_BARRIER();
#pragma unroll 1
            for (int n = 0; n < 32; ++n) {
                unsigned char* buf = c.lds + (n & 1) * SC_BUF;
                const int tok0 = b * SEQ + 64 * n;
                const float* ee = (const float*)(buf + SC_E);
                f32x4 Vn[4], O[4];
#pragma unroll
                for (int mt = 0; mt < 4; ++mt) { Vn[mt] = (f32x4){0.f, 0.f, 0.f, 0.f}; O[mt] = (f32x4){0.f, 0.f, 0.f, 0.f}; }
                bf16x8 BS[4];
#pragma unroll
                for (int s = 0; s < 4; ++s) BS[s] = pack8f(S[2 * s][0], S[2 * s][1], S[2 * s][2], S[2 * s][3], S[2 * s + 1][0], S[2 * s + 1][1], S[2 * s + 1][2], S[2 * s + 1][3]);
                bf16x8 fa[16];
#pragma unroll
                for (int mt = 0; mt < 4; ++mt)
#pragma unroll
                    for (int s = 0; s < 4; ++s) fa[mt * 4 + s] = *(const bf16x8*)(buf + SC_W + (16 * mt + m) * 272 + (8 * s + 2 * g) * 8);
                __builtin_amdgcn_sched_barrier(0);
#pragma unroll
                for (int mt = 0; mt < 4; ++mt)
#pragma unroll
                    for (int s = 0; s < 4; ++s) Vn[mt] = MFMA16(fa[mt * 4 + s], BS[s], Vn[mt]);
                __builtin_amdgcn_sched_barrier(0);
#pragma unroll
                for (int mt = 0; mt < 4; ++mt)
#pragma unroll
                    for (int s = 0; s < 4; ++s) fa[mt * 4 + s] = *(const bf16x8*)(buf + SC_Q + (16 * mt + m) * 272 + (8 * s + 2 * g) * 8);
                __builtin_amdgcn_sched_barrier(0);
#pragma unroll
                for (int mt = 0; mt < 4; ++mt)
#pragma unroll
                    for (int s = 0; s < 4; ++s) O[mt] = MFMA16(fa[mt * 4 + s], BS[s], O[mt]);
                __builtin_amdgcn_sched_barrier(0);
                bf16x8 fb2[8];
#pragma unroll
                for (int mt = 0; mt < 4; ++mt)
#pragma unroll
                    for (int s = 0; s < 2; ++s) fb2[mt * 2 + s] = *(const bf16x8*)(buf + SC_A + (16 * mt + m) * 144 + (8 * s + 2 * g) * 8);
#pragma unroll
                for (int dt = 0; dt < 4; ++dt)
#pragma unroll
                    for (int s = 0; s < 2; ++s) fa[dt * 2 + s] = *(const bf16x8*)(buf + SC_K + (16 * dt + m) * 144 + (8 * s + 2 * g) * 8);
                bf16x8 BV[2], BVd[2];
                {
                    f32x4 eg[4], ed[4];
#pragma unroll
                    for (int mt = 0; mt < 4; ++mt) { eg[mt] = *(const f32x4*)(ee + 16 * mt + 4 * g); ed[mt] = *(const f32x4*)(ee + 64 + 16 * mt + 4 * g); O[mt] *= eg[mt];
                        const u32x2 w = *(const u32x2*)(buf + SC_U + (16 * c.wid + m) * 144 + (16 * mt + 4 * g) * 2);
                        Vn[mt] += (f32x4){lo2f(w.x), hi2f(w.x), lo2f(w.y), hi2f(w.y)}; }
#pragma unroll
                    for (int s = 0; s < 2; ++s) {
                        const f32x4 a = Vn[2 * s], bq = Vn[2 * s + 1], ad = a * ed[2 * s], bd = bq * ed[2 * s + 1];
                        BV[s] = pack8f(a[0], a[1], a[2], a[3], bq[0], bq[1], bq[2], bq[3]);
                        BVd[s] = pack8f(ad[0], ad[1], ad[2], ad[3], bd[0], bd[1], bd[2], bd[3]);
                    }
                }
#pragma unroll
                for (int mt = 0; mt < 4; ++mt)
#pragma unroll
                    for (int s = 0; s < 2; ++s) O[mt] = MFMA16(fb2[mt * 2 + s], BV[s], O[mt]);
                const float glv = ee[128];
#pragma unroll
                for (int dt = 0; dt < 8; ++dt) S[dt] *= glv;
#pragma unroll
                for (int dt = 0; dt < 4; ++dt)
#pragma unroll
                    for (int s = 0; s < 2; ++s) S[dt] = MFMA16(fa[dt * 2 + s], BVd[s], S[dt]);
                __builtin_amdgcn_sched_barrier(0);
#pragma unroll
                for (int dt = 0; dt < 4; ++dt)
#pragma unroll
                    for (int s = 0; s < 2; ++s) fa[8 + dt * 2 + s] = *(const bf16x8*)(buf + SC_K + (16 * (4 + dt) + m) * 144 + (8 * s + 2 * g) * 8);
                __builtin_amdgcn_sched_barrier(0);
#pragma unroll
                for (int dt = 0; dt < 4; ++dt)
#pragma unroll
                    for (int s = 0; s < 2; ++s) S[4 + dt] = MFMA16(fa[8 + dt * 2 + s], BVd[s], S[4 + dt]);
#pragma unroll
                for (int mt = 0; mt < 4; ++mt)
#pragma unroll
                    for (int r = 0; r < 4; ++r) Og[(size_t)(tok0 + 16 * mt + 4 * g + r) * DM + h * 128 + col0 + m] = f2bf(O[mt][r]);
                LDS_BARRIER();
            }
        }
#undef SC_LOAD
#undef SC_WRITE
#undef SC_P
    }
}

DI void gdn_gnorm_phase(const Ctx& c, const bf16_t* O, const bf16_t* Pz, const float* onorm  , bf16_t* og) {
    const int gw = c.bid * NWAVES + c.wid, GW = c.G * NWAVES;
    const f32x4 wa = *(const f32x4*)(onorm + 8 * (c.lane & 15)), wb = *(const f32x4*)(onorm + 8 * (c.lane & 15) + 4);
    for (int tok = gw; tok < M_TOK; tok += 2 * GW) {
        u32x4 ow[2][4], zw[2][4];
#pragma unroll
        for (int r = 0; r < 2; ++r)
#pragma unroll
            for (int i = 0; i < 4; ++i) { const size_t off = (size_t)(tok + r * GW) * DM + 512 * i + 8 * c.lane; ow[r][i] = *(const u32x4*)(O + off); zw[r][i] = *(const u32x4*)(Pz + off); }
#pragma unroll
        for (int r = 0; r < 2; ++r)
#pragma unroll
            for (int i = 0; i < 4; ++i) {
                const u32x4 a = ow[r][i], z = zw[r][i];
                float o[8] = {lo2f(a.x), hi2f(a.x), lo2f(a.y), hi2f(a.y), lo2f(a.z), hi2f(a.z), lo2f(a.w), hi2f(a.w)};
                const float zz[8] = {lo2f(z.x), hi2f(z.x), lo2f(z.y), hi2f(z.y), lo2f(z.z), hi2f(z.z), lo2f(z.w), hi2f(z.w)};
                float ss = 0.f;
#pragma unroll
                for (int e = 0; e < 8; ++e) ss += o[e] * o[e];
                ss += dpp_mov<0xB1>(ss); ss += dpp_mov<0x4E>(ss); ss += dpp_mov<0x141>(ss); ss += dpp_mov<0x140>(ss);
                const float rs = rsqrtf(ss * (1.0f / 128.0f) + NORM_EPS);
#pragma unroll
                for (int e = 0; e < 4; ++e) { o[e] = o[e] * rs * wa[e] * silu_f(zz[e]); o[4 + e] = o[4 + e] * rs * wb[e] * silu_f(zz[4 + e]); }
                u32x4 w; w.x = pack2(o[0], o[1]); w.y = pack2(o[2], o[3]); w.z = pack2(o[4], o[5]); w.w = pack2(o[6], o[7]);
                *(u32x4*)(og + (size_t)(tok + r * GW) * DM + 512 * i + 8 * c.lane) = w;
            }
    }
}

DI void rope_k_phase(const Ctx& c, bf16_t* T, const float* ctab, const float* stab) {
    for (int i = c.bid * NTHREADS + c.tid; i < 32 * 2048 * 16; i += c.G * NTHREADS) {
        const int j = i & 15, row = i >> 4, bg = row >> 11, s = row & 2047, tok = (bg >> 2) * 2048 + s;
        const float cs = ctab[tok * 16 + j], sn = stab[tok * 16 + j];
        bf16_t* p = T + (size_t)row * 128;
        const float x1 = bf2f(p[j]), x2 = bf2f(p[16 + j]);
        p[j] = f2bf(x1 * cs - x2 * sn); p[16 + j] = f2bf(x2 * cs + x1 * sn);
    }
}
DI void rope_q_phase(const Ctx& c, const bf16_t* Q, bf16_t* QR, const float* ctab, const float* stab) {
    for (int i = c.bid * NTHREADS + c.tid; i < NB * 16 * 2048 * 16; i += c.G * NTHREADS) {
        const int ch = i & 15, row = i >> 4, b = row >> 15, s = row & 2047, tok = b * 2048 + s;
        const bf16_t* q = Q + (size_t)row * 128; bf16_t* o = QR + (size_t)row * 128;
        if (ch >= 4) { *(u32x4*)(o + 8 * ch) = *(const u32x4*)(q + 8 * ch); }
        else if (ch < 2) {
            const u32x4 a = *(const u32x4*)(q + 8 * ch), bq = *(const u32x4*)(q + 16 + 8 * ch);
            u32x4 ra, rb;
#pragma unroll
            for (int e = 0; e < 4; ++e) {
                const int j0 = 8 * ch + 2 * e;
                const float c0 = ctab[tok * 16 + j0], s0 = stab[tok * 16 + j0], c1 = ctab[tok * 16 + j0 + 1], s1 = stab[tok * 16 + j0 + 1];
                const float x10 = lo2f(a[e]), x11 = hi2f(a[e]), x20 = lo2f(bq[e]), x21 = hi2f(bq[e]);
                ra[e] = pack2(x10 * c0 - x20 * s0, x11 * c1 - x21 * s1);
                rb[e] = pack2(x20 * c0 + x10 * s0, x21 * c1 + x11 * s1);
            }
            *(u32x4*)(o + 8 * ch) = ra; *(u32x4*)(o + 16 + 8 * ch) = rb;
        }
    }
}
DI void cmp_w2_phase(const Ctx& c, const float* part, const float* biask, const float* biasv, const bf16_t* w2kt, bf16_t* kc, const bf16_t* w2vt, bf16_t* vc) {
    constexpr int HS = 520;
    bf16_t* Hl = (bf16_t*)c.lds;
    for (int item = c.bid; item < 128; item += c.G) {
        const int lane = lane_id(), tid = c.wid * 64 + lane, m = lane & 15, g = lane >> 4;
        const int pr = item >> 6, r0 = (item & 63) * 64;
        const float* bias = pr ? biasv : biask; const bf16_t* Wt = pr ? w2vt : w2kt; bf16_t* out = pr ? vc : kc;
        __syncthreads();
        {
            const int row = tid >> 3, cb = (tid & 7) * 64;
            const float* p0 = part + ((size_t)(pr * 4) * 4096 + r0 + row) * 512 + cb;
#pragma unroll
            for (int q = 0; q < 4; ++q) {
                f32x4 v[4];
#pragma unroll
                for (int e = 0; e < 4; ++e) v[e] = *(const f32x4*)(bias + cb + 16 * q + 4 * e);
#pragma unroll
                for (int ks = 0; ks < 4; ++ks)
#pragma unroll
                    for (int e = 0; e < 4; ++e) v[e] += *(const f32x4*)(p0 + (size_t)ks * 4096 * 512 + 16 * q + 4 * e);
                u32x4 w0, w1;
                w0.x = pack2(silu_f(v[0][0]), silu_f(v[0][1])); w0.y = pack2(silu_f(v[0][2]), silu_f(v[0][3])); w0.z = pack2(silu_f(v[1][0]), silu_f(v[1][1])); w0.w = pack2(silu_f(v[1][2]), silu_f(v[1][3]));
                w1.x = pack2(silu_f(v[2][0]), silu_f(v[2][1])); w1.y = pack2(silu_f(v[2][2]), silu_f(v[2][3])); w1.z = pack2(silu_f(v[3][0]), silu_f(v[3][1])); w1.w = pack2(silu_f(v[3][2]), silu_f(v[3][3]));
                *(u32x4*)(Hl + row * HS + cb + 16 * q) = w0; *(u32x4*)(Hl + row * HS + cb + 16 * q + 8) = w1;
            }
        }
        __syncthreads();
        const bf16_t* bp = Wt + (size_t)(16 * c.wid + m) * 512 + 8 * g;
        f32x4 acc[4];
#pragma unroll
        for (int mt = 0; mt < 4; ++mt) acc[mt] = (f32x4){0.f, 0.f, 0.f, 0.f};
#pragma unroll
        for (int bt = 0; bt < 4; ++bt) {
            bf16x8 bfr[4];
#pragma unroll
            for (int s = 0; s < 4; ++s) bfr[s] = *(const bf16x8*)(bp + 32 * (4 * bt + s));
#pragma unroll
            for (int s = 0; s < 4; ++s)
#pragma unroll
                for (int mt = 0; mt < 4; ++mt) acc[mt] = MFMA16(*(const bf16x8*)(Hl + (16 * mt + m) * HS + 32 * (4 * bt + s) + 8 * g), bfr[s], acc[mt]);
        }
#pragma unroll
        for (int mt = 0; mt < 4; ++mt)
#pragma unroll
            for (int r = 0; r < 4; ++r) out[(size_t)(r0 + 16 * mt + 4 * g + r) * 128 + 16 * c.wid + m] = f2bf(acc[mt][r]);
    }
}

DI void moe_route_phase(const Ctx& c, const float* rl, unsigned* gcnt, int* tok_e, int* tok_r, float* tok_w) {
    int* lcnt = (int*)c.lds; int* lbase = lcnt + 8;
    for (int chunk = c.bid; chunk < M_TOK / 64; chunk += c.G) {
        __syncthreads();
        if (c.tid < 8) lcnt[c.tid] = 0;
        __syncthreads();
        int e0 = 0, e1 = 1, r0 = 0, r1 = 0; float w0 = 0.f, w1 = 0.f;
        const int tok = chunk * 64 + c.tid;
        if (c.tid < 64) {
            const f32x4 a = *(const f32x4*)(rl + (size_t)tok * 8), b = *(const f32x4*)(rl + (size_t)tok * 8 + 4);
            const float lg[8] = {a[0], a[1], a[2], a[3], b[0], b[1], b[2], b[3]};
            float m0 = lg[0]; e0 = 0;
#pragma unroll
            for (int e = 1; e < 8; ++e) if (lg[e] > m0) { m0 = lg[e]; e0 = e; }
            float m1 = -3.0e38f; e1 = -1;
#pragma unroll
            for (int e = 0; e < 8; ++e) if (e != e0 && (e1 < 0 || lg[e] > m1)) { m1 = lg[e]; e1 = e; }
            w0 = 1.0f / (1.0f + __expf(m1 - m0)); w1 = 1.0f - w0;
            r0 = atomicAdd(&lcnt[e0], 1); r1 = atomicAdd(&lcnt[e1], 1);
        }
        __syncthreads();
        if (c.tid < 8) lbase[c.tid] = (int)__hip_atomic_fetch_add(gcnt + c.tid, (unsigned)lcnt[c.tid], __ATOMIC_RELAXED, __HIP_MEMORY_SCOPE_AGENT);
        __syncthreads();
        if (c.tid < 64) {
            tok_e[tok * 2] = e0; tok_e[tok * 2 + 1] = e1;
            tok_r[tok * 2] = lbase[e0] + r0; tok_r[tok * 2 + 1] = lbase[e1] + r1;
            tok_w[tok * 2] = w0; tok_w[tok * 2 + 1] = w1;
        }
    }
}
DI void moe_gather_phase(const Ctx& c, unsigned* gcnt, const int* tok_e, const int* tok_r, const float* tok_w, int* tokof, int* slot_of, float* roww, int* tile_e) {
    int* segb = (int*)c.lds;
    __syncthreads();
    if (c.tid == 0) { int run = 0;
#pragma unroll 1
        for (int e = 0; e < 8; ++e) { const int cnt = (int)__hip_atomic_load(gcnt + e, __ATOMIC_RELAXED, __HIP_MEMORY_SCOPE_AGENT); segb[e] = run;
            const int nt = (cnt + 255) >> 8;
            if (c.bid == 0) {
#pragma unroll 1
                for (int t = 0; t < nt; ++t) tile_e[(run >> 8) + t] = e; }
            run += nt << 8; }
        if (c.bid == 0) tile_e[160] = run >> 8; }
    __syncthreads();
    for (int i = c.bid * NTHREADS + c.tid; i < 2 * M_TOK; i += c.G * NTHREADS) {
        const int e = tok_e[i], slot = segb[e] + tok_r[i];
        slot_of[i] = slot; roww[slot] = tok_w[i]; tokof[slot] = i >> 1;
    }
}

namespace att {
constexpr int SHM_K = 16384, SHM_V = 16384;
constexpr int OFF_V = 0, OFF_K = 32768, OFF_WS = 65536, OFF_IMP = 73728, OFF_SEL = OFF_IMP + 8 * 32 * 33 * 4, OFF_UN = OFF_SEL + 256, OFF_SCL = OFF_UN + 16, OFF_OUT = OFF_IMP;
static_assert(OFF_SCL + 64 * 33 * 4 <= 8 * 18176 && OFF_OUT + 65536 <= 8 * 18176, "attention lds map");
constexpr float SCALE = 0.08838834764831845f, THR = 8.f;
#define KSWZ(row, colB) ((row) * 256 + ((colB) ^ (((row) & 7) << 4)))
DI int v_st(int k, int c) { const int kk = (k & ~0xC) | ((k & 4) << 1) | ((k & 8) >> 1); return ((kk >> 3) * 4 + (c >> 5)) * 512 + ((kk & 7) * 32 + (c & 31)) * 2; }
DI int v_rd_base(int lane) { return ((lane & 3) << 3) | (((lane >> 2) & 3) << 6) | (((lane >> 4) & 1) << 5) | (((lane >> 5) & 1) << 8); }
constexpr int v_rd_off(int d0, int ks, int half) { return d0 * 512 + ks * 4096 + half * 2048; }
typedef short s16x4 __attribute__((ext_vector_type(4)));
DI void mask_tile(f32x16& p0, f32x16& p1, int dq, unsigned W) {
    const float NEG = -__builtin_inff();
#pragma unroll
    for (int r = 0; r < 16; ++r) { const int cc = (r & 3) + 8 * (r >> 2);
        if ((unsigned)(dq - cc) >= W) p0[r] = NEG;
        if ((unsigned)(dq - cc - 32) >= W) p1[r] = NEG; }
}
DI void partialSM(f32x16& p0, f32x16& p1, float& m_reg, float& mn, float& alpha) {
    float pmax = p0[0];
#pragma unroll
    for (int r = 1; r < 16; ++r) pmax = fmaxf(pmax, p0[r]);
#pragma unroll
    for (int r = 0; r < 16; ++r) pmax = fmaxf(pmax, p1[r]);
    { auto rr = __builtin_amdgcn_permlane32_swap(__float_as_uint(pmax), __float_as_uint(pmax), false, false); pmax = fmaxf(__uint_as_float(rr[0]), __uint_as_float(rr[1])); }
    constexpr float C2 = 1.4426950408889634f * SCALE;
    if (__builtin_expect(__all((pmax - m_reg) * SCALE <= THR), 1)) { mn = m_reg; alpha = 1.f; }
    else { mn = fmaxf(m_reg, pmax); alpha = __builtin_amdgcn_exp2f((m_reg - mn) * C2); m_reg = mn; }
    const float mnL = -mn * C2;
#pragma unroll
    for (int r = 0; r < 16; ++r) { p0[r] = __builtin_amdgcn_exp2f(fmaf(p0[r], C2, mnL)); p1[r] = __builtin_amdgcn_exp2f(fmaf(p1[r], C2, mnL)); }
}
DI void p_frags(const f32x16& p0, const f32x16& p1, bf16x8& pa0, bf16x8& pa1, bf16x8& pa2, bf16x8& pa3) {
#define PK4(P, B_, OUT) do { const unsigned a0 = pack2(P[B_ + 0], P[B_ + 1]), a1 = pack2(P[B_ + 2], P[B_ + 3]), b0 = pack2(P[B_ + 4], P[B_ + 5]), b1 = pack2(P[B_ + 6], P[B_ + 7]); \
        auto r0 = __builtin_amdgcn_permlane32_swap(a0, b0, false, false); auto r1 = __builtin_amdgcn_permlane32_swap(a1, b1, false, false); \
        u32x4 w = {r0[0], r1[0], r0[1], r1[1]}; OUT = __builtin_bit_cast(bf16x8, w); } while (0)
    PK4(p0, 0, pa0); PK4(p0, 8, pa1); PK4(p1, 0, pa2); PK4(p1, 8, pa3);
#undef PK4
}
DI float row_sum(const f32x16& p0, const f32x16& p1) {
    float ps = 0.f;
#pragma unroll
    for (int r = 0; r < 16; ++r) ps += p0[r] + p1[r];
    auto rr = __builtin_amdgcn_permlane32_swap(__float_as_uint(ps), __float_as_uint(ps), false, false);
    return __uint_as_float(rr[0]) + __uint_as_float(rr[1]);
}
DI void qkt(f32x16& p0, f32x16& p1, const unsigned char* kbuf, int r32, int hi, const bf16x8* qr) {
    p0 = f32x16{}; p1 = f32x16{};
    const unsigned char* kb[4];
#pragma unroll
    for (int dd = 0; dd < 4; ++dd) kb[dd] = kbuf + KSWZ(r32, (dd * 16 + hi * 8) * 2);
#pragma unroll
    for (int d0 = 0; d0 < 8; ++d0) { const unsigned char* a = kb[d0 & 3] + (d0 >> 2) * 128;
        const bf16x8 b0 = *(const bf16x8*)a, b1 = *(const bf16x8*)(a + 32 * 256);
        p0 = MFMA32(b0, qr[d0], p0); p1 = MFMA32(b1, qr[d0], p1); }
}
DI void pv_tile(f32x16* o, int vb0, bf16x8 pa0, bf16x8 pa1, bf16x8 pa2, bf16x8 pa3) {
#define TRRD(dst, off) asm volatile("ds_read_b64_tr_b16 %0, %1 offset:%2" : "=&v"(dst) : "v"(vb0), "i"(off) : "memory")
#define PV_D0(d0) do { s16x4 l0, l1, l2, l3, h0, h1, h2, h3; constexpr int b_ = v_rd_off(d0, 0, 0); \
        TRRD(l0, b_); TRRD(h0, b_ + 2048); TRRD(l1, b_ + 4096); TRRD(h1, b_ + 6144); TRRD(l2, b_ + 8192); TRRD(h2, b_ + 10240); TRRD(l3, b_ + 12288); TRRD(h3, b_ + 14336); \
        asm volatile("s_waitcnt lgkmcnt(0)" ::: "memory"); __builtin_amdgcn_sched_barrier(0); \
        o[d0] = MFMA32(pa0, ((bf16x8){l0[0], l0[1], l0[2], l0[3], h0[0], h0[1], h0[2], h0[3]}), o[d0]); \
        o[d0] = MFMA32(pa1, ((bf16x8){l1[0], l1[1], l1[2], l1[3], h1[0], h1[1], h1[2], h1[3]}), o[d0]); \
        o[d0] = MFMA32(pa2, ((bf16x8){l2[0], l2[1], l2[2], l2[3], h2[0], h2[1], h2[2], h2[3]}), o[d0]); \
        o[d0] = MFMA32(pa3, ((bf16x8){l3[0], l3[1], l3[2], l3[3], h3[0], h3[1], h3[2], h3[3]}), o[d0]); } while (0)
    PV_D0(0); PV_D0(1); PV_D0(2); PV_D0(3);
#undef PV_D0
#undef TRRD
}
struct TileOff { unsigned k[2], v[2]; };
DI TileOff tile_offsets(int wid, int lane) {
    TileOff t;
#pragma unroll
    for (int i = 0; i < 2; ++i) {
        const int P = i * 8192 + wid * 1024 + lane * 16;
        const int row = P >> 8, cpos = (P & 255) >> 4; t.k[i] = (unsigned)(row * 256 + ((cpos ^ (row & 7)) << 4));
        const int sub = P >> 9, off = P & 511, kk = (sub >> 2) * 8 + (off >> 6), col = (sub & 3) * 32 + ((off & 63) >> 1);
        const int key = (kk & ~0xC) | ((kk & 4) << 1) | ((kk & 8) >> 1);
        t.v[i] = (unsigned)(key * 256 + col * 2);
    }
    return t;
}
DI void tile_dma(unsigned char* lds, int buf, const bf16_t* Kt, const bf16_t* Vt, int wid, const TileOff& t) {
    LAS unsigned char* l = (LAS unsigned char*)lds;
#pragma unroll
    for (int i = 0; i < 2; ++i) {
        __builtin_amdgcn_global_load_lds((const unsigned*)((const char*)Kt + t.k[i]), (LAS unsigned*)(l + OFF_K + buf * SHM_K + i * 8192 + wid * 1024), 16, 0, 0);
        __builtin_amdgcn_global_load_lds((const unsigned*)((const char*)Vt + t.v[i]), (LAS unsigned*)(l + OFF_V + buf * SHM_V + i * 8192 + wid * 1024), 16, 0, 0);
    }
}
#define ATT_PUBLISH() do { asm volatile("s_waitcnt vmcnt(0)" ::: "memory"); __syncthreads(); } while (0)
DI void rescale(f32x16* o, float alpha, float* al_l, int r32, int hi) {
    if (__any(alpha < 1.f)) { if (hi == 0) al_l[r32] = alpha; asm volatile("s_waitcnt lgkmcnt(0)" ::: "memory");
#pragma unroll
        for (int r = 0; r < 16; ++r) { const float a = al_l[crow32(r, hi)];
#pragma unroll
            for (int d = 0; d < 4; ++d) o[d][r] *= a; } }
}
template <int MODE>
DI void flash_branch(unsigned char* lds, const bf16_t* Kb, const bf16_t* Vb, const bf16x8* qr, unsigned tmask, unsigned selbits, int n, int qpos,
                     f32x16* o, float& l_reg, float* al_l, int r32, int hi, int wid, const TileOff& toff, int lane) {
    float m_reg = -1e30f; l_reg = 0.f;
#pragma unroll
    for (int d = 0; d < 4; ++d) o[d] = f32x16{};
    unsigned rest = tmask;
    int jc = __builtin_ctz(rest); rest &= rest - 1;
    tile_dma(lds, 0, Kb + (size_t)jc * 64 * 128, Vb + (size_t)jc * 64 * 128, wid, toff);
    ATT_PUBLISH();
    int bc = 0;
    for (;;) {
        const bool have_n = rest != 0u; const int jn = have_n ? __builtin_ctz(rest) : 0; if (have_n) rest &= rest - 1;
        if (have_n) tile_dma(lds, bc ^ 1, Kb + (size_t)jn * 64 * 128, Vb + (size_t)jn * 64 * 128, wid, toff);
        f32x16 p0, p1;
        qkt(p0, p1, lds + OFF_K + bc * SHM_K, r32, hi, qr);
        if (MODE == 0) {
            if (!((selbits >> jc) & 1u)) { const float NEG = -__builtin_inff();
#pragma unroll
                for (int r = 0; r < 16; ++r) { p0[r] = NEG; p1[r] = NEG; } }
            else if (jc == n) mask_tile(p0, p1, qpos - 64 * jc - 4 * hi, 0x40000000u);
        } else {
            if (jc == n || jc + 8 <= n) mask_tile(p0, p1, qpos - 64 * jc - 4 * hi, 512u);
        }
        float mn, alpha;
        partialSM(p0, p1, m_reg, mn, alpha);
        l_reg = l_reg * alpha + row_sum(p0, p1);
        bf16x8 pa0, pa1, pa2, pa3;
        p_frags(p0, p1, pa0, pa1, pa2, pa3);
        rescale(o, alpha, al_l, r32, hi);
        pv_tile(o, (int)(uintptr_t)(lds + OFF_V + bc * SHM_V) + v_rd_base(lane), pa0, pa1, pa2, pa3);
        if (!have_n) break;
        ATT_PUBLISH();
        bc ^= 1; jc = jn;
    }
    ATT_PUBLISH();
}
}

DI void nsa_attn_phase(const Ctx& c, const bf16_t* Q, const bf16_t* QR, const bf16_t* skv, const bf16_t* kcmp, const bf16_t* vcmp, const float* gates, bf16_t* PC, bf16_t* PS, bf16_t* AO) {
    using namespace att;
    unsigned char* lds = c.lds;
    const int hh = c.wid >> 1, th = c.wid & 1;
    const size_t TSZ = (size_t)32 * 2048 * 128;
    float* wsf = (float*)(lds + OFF_WS + c.wid * 1024); float* li_l = wsf; float* al_l = wsf + 32; float* gl = wsf + 64;
    float* impw = (float*)(lds + OFF_IMP); unsigned* selm = (unsigned*)(lds + OFF_SEL); unsigned* unw = (unsigned*)(lds + OFF_UN); float* scl = (float*)(lds + OFF_SCL);
    for (int i = 0;; ++i) {
        const int L = i * c.G + c.bid; if (L >= 1024) break;
        int lane_ = lane_id();
        const int lane = lane_, r32 = lane & 31, hi = lane >> 5, tid = c.wid * 64 + lane;
        const int k = L >> 8, rr = L & 255, jj = rr >> 5, bg = rr & 31;
        const int n = (k == 0) ? 31 - jj : (k == 1) ? 16 + jj : (k == 2) ? 15 - jj : jj;
        const int b = bg >> 2, g = bg & 3, head = 4 * g + hh, t0 = 64 * n, qpos = t0 + 32 * th + r32, tok = b * SEQ + qpos;
        const size_t qoff = ((size_t)(b * 16 + head) * 2048 + qpos) * 128 + 8 * hi;
        const size_t obase = (size_t)(b * SEQ + t0 + 32 * th) * DM + head * 128 + r32;
        bf16x8 qr[8];
#pragma unroll
        for (int d0 = 0; d0 < 8; ++d0) qr[d0] = *(const bf16x8*)(Q + qoff + 16 * d0);
        if (hi == 0) { const float* gt = gates + (size_t)tok * 48 + head * 3; gl[r32] = fast_sigmoid(gt[0]); gl[32 + r32] = fast_sigmoid(gt[1]); gl[64 + r32] = fast_sigmoid(gt[2]); }
        if (tid == 0) unw[0] = 0u;
        if (tid < 64) selm[tid] = 0u;
        const TileOff toff = tile_offsets(c.wid, lane);
        tile_dma(lds, 0, kcmp + (size_t)bg * 128 * 128, vcmp + (size_t)bg * 128 * 128, c.wid, toff);
        tile_dma(lds, 1, kcmp + (size_t)bg * 128 * 128 + 64 * 128, vcmp + (size_t)bg * 128 * 128 + 64 * 128, c.wid, toff);
        ATT_PUBLISH();
        unsigned* Ool = (unsigned*)(lds + OFF_OUT + c.wid * 8192) + lane;
        unsigned oc_keep[4][8];
        {
            f32x16 pA0, pA1, pB0, pB1;
            qkt(pA0, pA1, lds + OFF_K, r32, hi, qr);
            qkt(pB0, pB1, lds + OFF_K + SHM_K, r32, hi, qr);
            const int cmax = (qpos >= 31) ? ((qpos - 31) >> 4) : -1, lim = cmax - 4 * hi;
            const float NEG = -__builtin_inff();
#pragma unroll
            for (int r = 0; r < 16; ++r) { const int cc = (r & 3) + 8 * (r >> 2);
                if (cc > lim) pA0[r] = NEG; if (cc + 32 > lim) pA1[r] = NEG; if (cc + 64 > lim) pB0[r] = NEG; if (cc + 96 > lim) pB1[r] = NEG; }
            float pmax = -1e30f;
#pragma unroll
            for (int r = 0; r < 16; ++r) pmax = fmaxf(fmaxf(pmax, pA0[r]), fmaxf(pA1[r], fmaxf(pB0[r], pB1[r])));
            { auto x = __builtin_amdgcn_permlane32_swap(__float_as_uint(pmax), __float_as_uint(pmax), false, false); pmax = fmaxf(__uint_as_float(x[0]), __uint_as_float(x[1])); }
            constexpr float C2 = 1.4426950408889634f * SCALE;
            const float mnL = -pmax * C2;
#pragma unroll
            for (int r = 0; r < 16; ++r) { pA0[r] = __builtin_amdgcn_exp2f(fmaf(pA0[r], C2, mnL)); pA1[r] = __builtin_amdgcn_exp2f(fmaf(pA1[r], C2, mnL));
                pB0[r] = __builtin_amdgcn_exp2f(fmaf(pB0[r], C2, mnL)); pB1[r] = __builtin_amdgcn_exp2f(fmaf(pB1[r], C2, mnL)); }
            const float l = row_sum(pA0, pA1) + row_sum(pB0, pB1);
            const float inv = (l > 0.f) ? 1.0f / l : 0.f;
#pragma unroll
            for (int r = 0; r < 16; ++r) { pA0[r] *= inv; pA1[r] *= inv; pB0[r] *= inv; pB1[r] *= inv; }
            float* myimp = impw + (size_t)(c.wid * 32 + r32) * 33;
#define IMP_MAIN(P, base) do { _Pragma("unroll") for (int q = 0; q < 4; ++q) myimp[(base) + 2 * q + hi] = 2.0f * (P[4 * q] + P[4 * q + 1] + P[4 * q + 2]) + P[4 * q + 3]; } while (0)
            IMP_MAIN(pA0, 0); IMP_MAIN(pA1, 8); IMP_MAIN(pB0, 16); IMP_MAIN(pB1, 24);
#undef IMP_MAIN
            asm volatile("s_waitcnt lgkmcnt(0)" ::: "memory");
#define IMP_CARRY(P, base) do { _Pragma("unroll") for (int q = 0; q < 4; ++q) { const int jn1 = (base) + 2 * q + hi + 1; if (jn1 < 32) myimp[jn1] += P[4 * q + 3]; } } while (0)
            IMP_CARRY(pA0, 0); IMP_CARRY(pA1, 8); IMP_CARRY(pB0, 16); IMP_CARRY(pB1, 24);
#undef IMP_CARRY
            bf16x8 pa0, pa1, pa2, pa3;
            f32x16 o[4];
#pragma unroll
            for (int d = 0; d < 4; ++d) o[d] = f32x16{};
            p_frags(pA0, pA1, pa0, pa1, pa2, pa3);
            pv_tile(o, (int)(uintptr_t)(lds + OFF_V) + v_rd_base(lane), pa0, pa1, pa2, pa3);
            p_frags(pB0, pB1, pa0, pa1, pa2, pa3);
            pv_tile(o, (int)(uintptr_t)(lds + OFF_V + SHM_V) + v_rd_base(lane), pa0, pa1, pa2, pa3);
            asm volatile("s_waitcnt lgkmcnt(0)" ::: "memory");
#pragma unroll
            for (int r = 0; r < 16; r += 2) { const float g0 = gl[crow32(r, hi)], g1 = gl[crow32(r + 1, hi)];
#pragma unroll
                for (int d = 0; d < 4; ++d) oc_keep[d][r >> 1] = pack2(o[d][r] * g0, o[d][r + 1] * g1); }
        }
        __syncthreads();
        {
            const int tt = tid & 63, jg = tid >> 6, tth = tt >> 5, tr = tt & 31, tpos = t0 + tt, cur = n;
            float mys[4];
#pragma unroll
            for (int e = 0; e < 4; ++e) { const int j = 4 * jg + e; float v = 0.f;
#pragma unroll
                for (int h4 = 0; h4 < 4; ++h4) v += impw[(size_t)((2 * h4 + tth) * 32 + tr) * 33 + j];
                const bool forced = (j == 0) || (j == cur) || (j == cur - 1), causal = (j * 64 <= tpos);
                mys[e] = forced ? 1e9f : (causal ? v : -1e9f); scl[tt * 33 + j] = mys[e]; }
            __syncthreads();
            int rank[4] = {0, 0, 0, 0};
#pragma unroll 4
            for (int j2 = 0; j2 < 32; ++j2) { const float s2 = scl[tt * 33 + j2];
#pragma unroll
                for (int e = 0; e < 4; ++e) rank[e] += (s2 > mys[e] || (s2 == mys[e] && j2 < 4 * jg + e)) ? 1 : 0; }
            unsigned bits = 0u;
#pragma unroll
            for (int e = 0; e < 4; ++e) bits |= (rank[e] < 16) ? (1u << (4 * jg + e)) : 0u;
            bits &= (cur >= 31) ? 0xffffffffu : ((2u << cur) - 1u);
            if (bits) { atomicOr(selm + tt, bits); atomicOr(unw, bits); }
        }
        __syncthreads();
        const unsigned selbits = selm[32 * th + r32], un = unw[0];
        __syncthreads();
#pragma unroll
        for (int d = 0; d < 4; ++d)
#pragma unroll
            for (int q = 0; q < 8; ++q) Ool[(d * 8 + q) * 64] = oc_keep[d][q];
#pragma unroll
        for (int d0 = 0; d0 < 8; ++d0) qr[d0] = *(const bf16x8*)(QR + qoff + 16 * d0);
        const bf16_t* kbase = skv + (size_t)bg * 2048 * 128;
        {
            f32x16 o[4]; float l_reg;
            flash_branch<0>(lds, kbase + 2 * TSZ, kbase + 3 * TSZ, qr, un, selbits, n, qpos, o, l_reg, al_l, r32, hi, c.wid, toff, lane);
            if (hi == 0) li_l[r32] = l_reg;
            asm volatile("s_waitcnt lgkmcnt(0)" ::: "memory");
#pragma unroll
            for (int r = 0; r < 16; r += 2) { const int c0 = crow32(r, hi), c1 = crow32(r + 1, hi);
                const float g0 = gl[32 + c0] * __builtin_amdgcn_rcpf(li_l[c0]), g1 = gl[32 + c1] * __builtin_amdgcn_rcpf(li_l[c1]);
#pragma unroll
                for (int d = 0; d < 4; ++d) { const unsigned pv_ = Ool[(d * 8 + (r >> 1)) * 64]; Ool[(d * 8 + (r >> 1)) * 64] = pack2(lo2f(pv_) + o[d][r] * g0, hi2f(pv_) + o[d][r + 1] * g1); } }
        }
        {
            f32x16 o[4]; float l_reg;
            const int jlo = (n >= 8) ? n - 8 : 0;
            const unsigned wmask = ((n >= 31) ? 0xffffffffu : ((2u << n) - 1u)) & ~((1u << jlo) - 1u);
            flash_branch<1>(lds, kbase + 4 * TSZ, kbase + 5 * TSZ, qr, wmask, 0u, n, qpos, o, l_reg, al_l, r32, hi, c.wid, toff, lane);
            if (hi == 0) li_l[r32] = l_reg;
            asm volatile("s_waitcnt lgkmcnt(0)" ::: "memory");
            bf16_t* otl = (bf16_t*)(lds + OFF_V + c.wid * 8192);
#pragma unroll
            for (int r = 0; r < 16; ++r) { const int c0 = crow32(r, hi); const float g0 = gl[64 + c0] * __builtin_amdgcn_rcpf(li_l[c0]);
#pragma unroll
                for (int d = 0; d < 4; ++d) { const unsigned pv_ = Ool[(d * 8 + (r >> 1)) * 64]; const float prev = (r & 1) ? hi2f(pv_) : lo2f(pv_);
                    otl[c0 * 128 + 32 * d + r32] = f2bf(prev + o[d][r] * g0); } }
            asm volatile("s_waitcnt lgkmcnt(0)" ::: "memory"); __builtin_amdgcn_wave_barrier();
            bf16_t* orow = AO + (size_t)(b * SEQ + t0 + 32 * th) * DM + head * 128;
#pragma unroll
            for (int j = 0; j < 8; ++j) { const int ci = lane + 64 * j, row = ci >> 4, cc = ci & 15;
                *(u32x4*)(orow + (size_t)row * DM + 8 * cc) = *(const u32x4*)(otl + 8 * ci); }
        }
        __syncthreads();
    }
}

constexpr int ST_OFF = 8 * SOLVE_WAVE_LDS;
constexpr int LDS_BYTES = ST_OFF + 1024;
static_assert(ST_OFF >= pg8::STAGE_BYTES && 2 * SC_BUF <= ST_OFF, "lds map");
constexpr int NPH_MAX = 48;
constexpr int BAR_REGION_WORD0 = 16384, BAR_REGION_STRIDE = 4096;
typedef const Params __attribute__((address_space(4)))* KArgs;

DI void cvt_layer(const Ctx& c, KArgs p, int l, int& tb) {
    bf16_t* WB = (bf16_t*)(p->ws + WS_WB);
    if (l < 2) {
        const float* win = p->in[I_GDN_W_IN] + (size_t)l * 2048 * 8224;
        cvt_task(c, tb, win, 8224, 2048, 8192, 8192, WB + WB_MIX_IN / 2, 0);
        cvt_task(c, tb, win + 8192, 8224, 2048, 32, 64, WB + WB_SMALL / 2, 0);
        cvt_task(c, tb, p->in[I_GDN_W_OUT] + (size_t)l * 2048 * 2048, 2048, 2048, 2048, 2048, WB + WB_MIX_OUT / 2, 0);
    } else {
        const int j = l - 2; const float* wq = p->in[I_NSA_W_Q] + (size_t)j * 2048 * 2096;
        cvt_task(c, tb, wq, 2096, 2048, 2048, 2048, WB + WB_MIX_IN / 2, 0);
        cvt_task(c, tb, wq + 2048, 2096, 2048, 48, 64, WB + WB_SMALL / 2, 0);
        cvt_task(c, tb, p->in[I_NSA_W_O] + (size_t)j * 2048 * 2048, 2048, 2048, 2048, 2048, WB + WB_MIX_OUT / 2, 0);
    }
    const int j = l >> 1;
    if ((l & 1) == 0) {
        cvt_task(c, tb, p->in[I_FFN_W_GATE] + (size_t)j * 2048 * FFN, FFN, 2048, FFN, FFN, WB + WB_FFN / 2, 1);
        cvt_task(c, tb, p->in[I_FFN_W_UP] + (size_t)j * 2048 * FFN, FFN, 2048, FFN, FFN, WB + WB_FFN / 2, 2);
        cvt_task(c, tb, p->in[I_FFN_W_DOWN] + (size_t)j * FFN * 2048, 2048, FFN, 2048, 2048, WB + WB_FFN_DOWN_DENSE / 2, 0);
    } else {
#pragma unroll 1
        for (int e = 0; e < NEXP; ++e) {
            const size_t wo = (size_t)(j * NEXP + e) * 2048 * 2048;
            cvt_task(c, tb, p->in[I_MOE_W_GATE] + wo, 2048, 2048, 2048, 2048, WB + WB_FFN / 2 + (size_t)e * 4096 * 2048, 1);
            cvt_task(c, tb, p->in[I_MOE_W_UP] + wo, 2048, 2048, 2048, 2048, WB + WB_FFN / 2 + (size_t)e * 4096 * 2048, 2);
            cvt_task(c, tb, p->in[I_MOE_W_DOWN] + wo, 2048, 2048, 2048, 2048, WB + WB_MOE_DOWN / 2 + (size_t)e * 2048 * 2048, 0);
        }
        cvt_task(c, tb, p->in[I_MOE_ROUTER] + (size_t)j * 2048 * 8, 8, 2048, 8, 64, WB + WB_ROUTER / 2, 0);
    }
}

#ifndef R_OUT
#define R_OUT 1
#endif
#ifndef R_DOWN
#define R_DOWN 1
#endif
#ifndef R_GATHER
#define R_GATHER 1
#endif
#ifndef R_CMP
#define R_CMP 1
#endif
#ifndef R_P0
#define R_P0 1
#endif
#ifndef R_FINAL
#define R_FINAL 1
#endif
#ifndef R_PRE
#define R_PRE 1
#endif
#ifndef R_CVT
#define R_CVT 1
#endif
#ifndef R_INPROJ
#define R_INPROJ 1
#endif
#ifndef R_GDN
#define R_GDN 1
#endif
#ifndef R_CONV
#define R_CONV 1
#endif
#ifndef R_SOLVE
#define R_SOLVE 1
#endif
#ifndef R_SCAN
#define R_SCAN 1
#endif
#ifndef R_QKV
#define R_QKV 1
#endif
#ifndef R_ATT
#define R_ATT 1
#endif
#ifndef R_FFNGU
#define R_FFNGU 1
#endif
#ifndef R_MOEG
#define R_MOEG 1
#endif
#ifndef R_NORM
#define R_NORM 1
#endif
__global__ void __launch_bounds__(NTHREADS, 2) mega_fwd(Params p_unused) {
    extern __shared__ __attribute__((aligned(16))) unsigned char shm[];
    LAS unsigned char* ldsl = (LAS unsigned char*)shm;
    volatile LAS unsigned* st = (volatile LAS unsigned*)(ldsl + ST_OFF);
    const int wid_s = __builtin_amdgcn_readfirstlane((int)threadIdx.x >> 6);
    if (wid_s == 0 && lane_id() == 0) { st[0] = 0u; st[1] = 0u; st[2] = 0u; st[3] = 0u; }
    __syncthreads();
    KArgs kargs = (KArgs)__builtin_amdgcn_kernarg_segment_ptr();
    const int lo = kargs->ph_lo, hi = kargs->ph_hi;
    XcdBarrier bar; bar.bar = (unsigned*)(kargs->ws + WS_CTL) + BAR_REGION_WORD0 + (lo & 63) * BAR_REGION_STRIDE; bar.x = 0; bar.st = st;
    if (hi - lo > 1) bar = xcd_barrier_post(bar.bar, st, wid_s * 64 + lane_id());

    int pc = 0;
#define PH_BEGIN PH_BEGIN_R(1)
#define PH_BEGIN_R(R) if (pc >= lo && pc < hi) { _Pragma("unroll 1") for (int rep_ = 0; rep_ < (R); ++rep_) { KArgs p = kargs; asm volatile("" : "+s"(p)); int tid_ = wid_s * 64 + lane_id(); asm volatile("" : "+v"(tid_)); \
        Ctx c; c.lds = shm; c.tid = tid_; c.lane = tid_ & 63; c.wid = wid_s; c.G = gridDim.x; c.bid = blockIdx.x; \
        unsigned char* ws = p->ws; (void)ws; (void)c;
#define PH_END   } if (pc + 1 < hi) xcd_barrier(bar, wid_s * 64 + lane_id()); } ++pc;
#define CTX_REFRESH do { int t2_ = wid_s * 64 + lane_id(); asm volatile("" : "+v"(t2_)); c.tid = t2_; c.lane = t2_ & 63; } while (0)
#define SLOTP(i) ((bf16_t*)(ws + WS_SL + (size_t)(i) * SLOT))
#define WBP(off) ((bf16_t*)(ws + WS_WB + (off)))
#define WKVP(off) ((bf16_t*)(ws + WS_WKV + (off)))
#define AUXP(T, off) ((T*)(ws + WS_AUX + (off)))
#define HP ((bf16_t*)(ws + WS_H))
#define SKVP ((bf16_t*)(ws + WS_SKV))
#define CTAB ((float*)(ws + WS_WKV + WKV_ROPE))
#define STAB (CTAB + (size_t)M_TOK * 16)
#define TILE_E ((int*)((unsigned*)(ws + WS_CTL) + CW_TILEE))
    constexpr size_t TSZ = (size_t)32 * 2048 * 128;

    PH_BEGIN_R(R_P0)
        int tb = 0;
        for (int rc_ = 1; rc_ < R_CVT; ++rc_) { int tb2 = 0; cvt_layer(c, p, 0, tb2); }
        cvt_task(c, tb, p->in[I_NSA_W_KV], 3072, 2048, 3072, 3072, WKVP(WKV_KV), 0);
        cvt_task(c, tb, p->in[I_CMP_W1_K], 512, 4096, 512, 512, WKVP(WKV_W1K), 0);
        cvt_task(c, tb, p->in[I_CMP_W1_V], 512, 4096, 512, 512, WKVP(WKV_W1V), 0);
        cvt_task(c, tb, p->in[I_CMP_W2_K], 128, 512, 128, 128, WKVP(WKV_W2K), 0);
        cvt_task(c, tb, p->in[I_CMP_W2_V], 128, 512, 128, 128, WKVP(WKV_W2V), 0);
        cvt_layer(c, p, 0, tb);
        rope_table_phase(c, (const int*)p->in[I_POS], CTAB, STAB);
        cmp_bias_phase(c, p->in[I_CMP_POS_K], p->in[I_CMP_W1_K], p->in[I_CMP_POS_V], p->in[I_CMP_W1_V], (float*)(ws + WS_WKV + WKV_BPART));
        CTX_REFRESH;
        norm_phase<true, 2>(c, p->in[I_X], nullptr, nullptr, nullptr, p->in[I_ATTN_NORM], SLOTP(0), nullptr, nullptr, nullptr);
    PH_END

#pragma unroll 1
    for (int l = 0; l < 4; ++l) {
        if (l > 0) {
            PH_BEGIN
                int tb = 0; cvt_layer(c, p, l, tb);
                if (l == 1) cmp_bias_reduce(c, (const float*)(ws + WS_WKV + WKV_BPART), (float*)(ws + WS_WKV + WKV_BIASK), (float*)(ws + WS_WKV + WKV_BIASV));
                for (int rc_ = 1; rc_ < R_CVT; ++rc_) { int tb2 = 0; cvt_layer(c, p, l, tb2); }
                CTX_REFRESH;
                if (l == 2) norm_phase<false, 2>(c, HP, SLOTP(7), AUXP(int, AUX_SLOTOF), HP, p->in[I_KV_NORM], SLOTP(1), p->in[I_ATTN_NORM] + 2 * DM, SLOTP(0), nullptr);
                else norm_phase<false, 4>(c, HP, nullptr, nullptr, nullptr, p->in[I_ATTN_NORM] + (size_t)l * DM, SLOTP(0), nullptr, nullptr, nullptr);
            PH_END
        }
        if (l < 2) {
            PH_BEGIN_R(R_INPROJ)
                { pg8::Gemm g{2048, 2048, 2048}; pg8::SchedDense S; S.init(M_TOK, 8192, c.G, c.bid, SLOTP(0), 2048, WBP(WB_MIX_IN), 2048);
                  pg8::EpiSplit E{SLOTP(1), 2048, 2048, (size_t)SLOT / 2};
                  pg8::gemm_phase(ldsl, g, S, E, wid_s * 64 + lane_id()); }
                CTX_REFRESH; skinny_phase<2>(c, SLOTP(0), WBP(WB_SMALL), AUXP(float, AUX_SK), 32, 32);
            PH_END
            PH_BEGIN_R(R_CONV)
                gdn_conv2_phase(c, SLOTP(1), SLOTP(2), SLOTP(3), p->in[I_GDN_CONV] + (size_t)l * 4 * 6144, AUXP(float, AUX_SK), p->in[I_GDN_A_LOG] + l * 16, p->in[I_GDN_DT_BIAS] + l * 16,
                                SLOTP(6), SLOTP(5), SLOTP(10), SLOTP(7), AUXP(float, AUX_G), AUXP(float, AUX_BETA));
                asm volatile("s_waitcnt vmcnt(0)" ::: "memory");
                CTX_REFRESH;
                gdn_solve_phase(c, SLOTP(6), SLOTP(5), SLOTP(10), SLOTP(7), AUXP(float, AUX_G), AUXP(float, AUX_BETA), SLOTP(0), SLOTP(11), SLOTP(9));
            PH_END
            PH_BEGIN_R(R_SCAN)
                gdn_scan_phase(c, SLOTP(6), SLOTP(10), SLOTP(0), SLOTP(11), SLOTP(9), AUXP(float, AUX_G), SLOTP(8));
            PH_END
            PH_BEGIN_R(R_GDN)
                gdn_gnorm_phase(c, SLOTP(8), SLOTP(4), p->in[I_GDN_OUT_NORM] + l * 128, SLOTP(9));
            PH_END
        } else {
            PH_BEGIN_R(R_QKV)
                if (l == 2) { pg8::Gemm g{2048, 2048, 2048}; pg8::SchedDense S; S.init(M_TOK, 3072, c.G, c.bid, SLOTP(1), 2048, WKVP(WKV_KV), 2048);
                  pg8::EpiHeads E{SKVP, 4, TSZ, (1u << 2) | (1u << 4), nullptr, CTAB, STAB};
                  pg8::gemm_phase(ldsl, g, S, E, wid_s * 64 + lane_id()); }
                CTX_REFRESH;
                { pg8::Gemm g{2048, 2048, 2048}; pg8::SchedDense S; S.init(M_TOK, 2048, c.G, c.bid, SLOTP(0), 2048, WBP(WB_MIX_IN), 2048);
                  pg8::EpiHeads E{SLOTP(2), 16, 0, 1u, SLOTP(3), CTAB, STAB};
                  pg8::gemm_phase(ldsl, g, S, E, wid_s * 64 + lane_id()); }
                CTX_REFRESH; skinny_phase<3>(c, SLOTP(0), WBP(WB_SMALL), AUXP(float, AUX_SK), 48, 48);
            PH_END
            if (l == 2) {
                PH_BEGIN_R(R_CMP)
                    pg8::Gemm g{1024, 2048, 4096}; pg8::SchedCmp S{c.G, c.bid, (const char*)SKVP, (const char*)(SKVP + TSZ), (const char*)WKVP(WKV_W1K), (const char*)WKVP(WKV_W1V)};
                    pg8::EpiCmp E{(float*)SLOTP(7)};
                    pg8::gemm_phase(ldsl, g, S, E, wid_s * 64 + lane_id());
                PH_END
                PH_BEGIN_R(R_CMP)
                    cmp_w2_phase(c, (const float*)SLOTP(7), (const float*)(ws + WS_WKV + WKV_BIASK), (const float*)(ws + WS_WKV + WKV_BIASV), WKVP(WKV_W2K), (bf16_t*)(ws + WS_SKV + SKV_KCMP), WKVP(WKV_W2V), (bf16_t*)(ws + WS_SKV + SKV_VCMP));
                PH_END
            }
            PH_BEGIN_R(R_ATT)
                nsa_attn_phase(c, SLOTP(2), SLOTP(3), SKVP, (const bf16_t*)(ws + WS_SKV + SKV_KCMP), (const bf16_t*)(ws + WS_SKV + SKV_VCMP), AUXP(float, AUX_SK), SLOTP(5), SLOTP(6), SLOTP(4));
            PH_END
        }
        PH_BEGIN_R(R_OUT)
            { const bf16_t* A = (l < 2) ? SLOTP(9) : SLOTP(4); const void* base = (l == 0) ? (const void*)p->in[I_X] : (const void*)HP;
              pg8::Gemm g{2048, 2048, 2048}; pg8::SchedDense S; S.init(M_TOK, 2048, c.G, c.bid, A, 2048, WBP(WB_MIX_OUT), 2048);
              pg8::EpiRes E{base, rep_ ? SLOTP(11) : HP, 2048, l == 0};
              pg8::gemm_phase(ldsl, g, S, E, wid_s * 64 + lane_id()); }
        PH_END
        PH_BEGIN
            norm_phase<false, 4>(c, HP, nullptr, nullptr, nullptr, p->in[I_FFN_NORM] + (size_t)l * DM, SLOTP(0), nullptr, nullptr, nullptr);
            if (l & 1) {
                asm volatile("s_waitcnt vmcnt(0)" ::: "memory"); __syncthreads();
                CTX_REFRESH; skinny_phase<1>(c, SLOTP(0), WBP(WB_ROUTER), AUXP(float, AUX_RL), 8, 8);
                asm volatile("s_waitcnt vmcnt(0)" ::: "memory"); __syncthreads();
                CTX_REFRESH; moe_route_phase(c, AUXP(float, AUX_RL), (unsigned*)(ws + WS_CTL) + CW_MOECNT + 64 * (l >> 1), AUXP(int, AUX_TOKE), AUXP(int, AUX_TOKR), AUXP(float, AUX_TOKW));
                for (int i = c.bid * NTHREADS + c.tid; i < 36864; i += c.G * NTHREADS) AUXP(int, AUX_TOKOF)[i] = 0;
            }
        PH_END
        if ((l & 1) == 0) {
            PH_BEGIN_R(R_FFNGU)
                { pg8::Gemm g{2048, 2048, 2048}; pg8::SchedDense S; S.init(M_TOK, 2 * FFN, c.G, c.bid, SLOTP(0), 2048, WBP(WB_FFN), 2048);
                  pg8::EpiSwiglu E{SLOTP(1), FFN};
                  pg8::gemm_phase(ldsl, g, S, E, wid_s * 64 + lane_id()); }
            PH_END
            PH_BEGIN_R(R_DOWN)
                { pg8::Gemm g{FFN, FFN, FFN}; pg8::SchedDense S; S.init(M_TOK, 2048, c.G, c.bid, SLOTP(1), FFN, WBP(WB_FFN_DOWN_DENSE), FFN);
                  pg8::EpiRes E{HP, rep_ ? SLOTP(11) : HP, 2048, false};
                  pg8::gemm_phase(ldsl, g, S, E, wid_s * 64 + lane_id()); }
            PH_END
        } else {
            PH_BEGIN_R(R_GATHER)
                moe_gather_phase(c, (unsigned*)(ws + WS_CTL) + CW_MOECNT + 64 * (l >> 1), AUXP(int, AUX_TOKE), AUXP(int, AUX_TOKR), AUXP(float, AUX_TOKW), AUXP(int, AUX_TOKOF), AUXP(int, AUX_SLOTOF), AUXP(float, AUX_ROWW), TILE_E);
            PH_END
#pragma unroll 1
            for (int sp = 0; sp < 3; ++sp) {
                PH_BEGIN_R(R_MOEG)
                    { const int nMt = TILE_E[160], T1 = nMt < 112 ? nMt : 112;
                      pg8::Gemm g{2048, 2048, 2048};
                      pg8::SchedMoe2 S{sp == 0 ? 0 : T1, sp == 0 ? T1 : (sp == 1 ? nMt : T1), sp == 1 ? 0 : T1, sp == 0 ? T1 : (sp == 1 ? T1 : nMt), c.G, c.bid,
                                       (const char*)SLOTP(0), (const char*)WBP(WB_FFN), (const char*)SLOTP(4), (const char*)WBP(WB_MOE_DOWN), TILE_E, AUXP(int, AUX_TOKOF)};
                      pg8::EpiMoe E{SLOTP(4), SLOTP(7), AUXP(float, AUX_ROWW)};
                      pg8::gemm_phase<pg8::EpiMoe, pg8::SchedMoe2, true>(ldsl, g, S, E, wid_s * 64 + lane_id()); }
                PH_END
            }
        }
    }
    PH_BEGIN_R(R_FINAL)
        norm_phase<false, 2>(c, HP, SLOTP(7), AUXP(int, AUX_SLOTOF), nullptr, p->in[I_FINAL_NORM], nullptr, nullptr, nullptr, p->out);
    PH_END
#undef PH_BEGIN
#undef PH_END
}

#ifndef MK_ONE_LAUNCH
#define MK_ONE_LAUNCH 1
#endif
extern "C" void kernel_launch(void* const* d_in, const int* in_sizes, int n_in, void* d_out, int out_size, void* d_ws, size_t ws_size, hipStream_t stream) {
    static int grid = 0;
    if (grid == 0) {
        if (n_in != 28 || out_size != M_TOK * DM || ws_size < WS_END) { fprintf(stderr, "kernel_launch: unexpected shapes (n_in %d out %d ws %zu need %zu)\n", n_in, out_size, ws_size, (size_t)WS_END); grid = -1; return; }
        int dev = 0, cus = 0, per_cu = 0;
        if (hipGetDevice(&dev) != hipSuccess || hipDeviceGetAttribute(&cus, hipDeviceAttributeMultiprocessorCount, dev) != hipSuccess) { grid = -1; return; }
        if (hipFuncSetAttribute((const void*)mega_fwd, hipFuncAttributeMaxDynamicSharedMemorySize, LDS_BYTES) != hipSuccess) { fprintf(stderr, "kernel_launch: hipFuncSetAttribute failed\n"); grid = -1; return; }
        if (hipOccupancyMaxActiveBlocksPerMultiprocessor(&per_cu, (const void*)mega_fwd, NTHREADS, LDS_BYTES) != hipSuccess || per_cu < 1) { fprintf(stderr, "kernel_launch: occupancy query says %d\n", per_cu); }
        (void)hipGetLastError();
        grid = cus;
    }
    if (grid < 0) return;
    if (hipMemsetAsync((char*)d_ws + WS_CTL, 0, 1 * MiB, stream) != hipSuccess) return;
    Params p{};
    for (int i = 0; i < 28; ++i) p.in[i] = (const float*)d_in[i];
    p.out = (float*)d_out; p.ws = (unsigned char*)d_ws;
#if MK_ONE_LAUNCH
    p.ph_lo = 0; p.ph_hi = NPH_MAX;
    hipLaunchKernelGGL(mega_fwd, dim3(grid), dim3(NTHREADS), LDS_BYTES, stream, p);
#else
    for (int i = 0; i < 43; ++i) { p.ph_lo = i; p.ph_hi = i + 1; hipLaunchKernelGGL(mega_fwd, dim3(grid), dim3(NTHREADS), LDS_BYTES, stream, p); }
#endif
}
```

```cpp
#include <hip/hip_runtime.h>
#include <stdint.h>
#include <stdio.h>

#define LAS __attribute__((address_space(3)))
typedef unsigned short bf16_t;
typedef short bf16x8 __attribute__((ext_vector_type(8)));
typedef float f32x4 __attribute__((ext_vector_type(4)));
typedef float f32x2 __attribute__((ext_vector_type(2)));
typedef unsigned u32x4 __attribute__((ext_vector_type(4)));
typedef unsigned u32x2 __attribute__((ext_vector_type(2)));
typedef __bf16 bfx2_t __attribute__((ext_vector_type(2)));
#define DI __device__ __forceinline__

constexpr int M_TOK = 16384, DM = 2048, NB = 8, SEQ = 2048;
constexpr int FFN = 5632, NEXP = 8, EDIM = 2048;
constexpr int NTHREADS = 512, NWAVES = 8;
constexpr float NORM_EPS = 1e-6f;
constexpr int MAX_SLOTS = 32768 + 8 * 256;

constexpr size_t MiB = 1024ull * 1024ull;
constexpr size_t WS_CTL = 0;
constexpr size_t WS_H = 1 * MiB;
constexpr size_t WS_WB = WS_H + 128 * MiB;
constexpr size_t WS_WKV = WS_WB + 234 * MiB;
constexpr size_t WS_SKV = WS_WKV + 24 * MiB;
constexpr size_t WS_AUX = WS_SKV + 100 * MiB;
constexpr size_t WS_SL = WS_AUX + 16 * MiB;
constexpr size_t SLOT = 64 * MiB;
constexpr size_t WS_END = WS_SL + 12 * SLOT;
constexpr size_t WB_MIX_IN = 0;
constexpr size_t WB_SMALL = 32 * MiB;
constexpr size_t WB_MIX_OUT = 33 * MiB;
constexpr size_t WB_FFN = 41 * MiB;
constexpr size_t WB_FFN_DOWN_DENSE = WB_FFN + 44 * MiB;
constexpr size_t WB_MOE_DOWN = WB_FFN + 128 * MiB;
constexpr size_t WB_ROUTER = WB_FFN + 192 * MiB;
constexpr size_t WKV_KV = 0;
constexpr size_t WKV_W1K = 12 * MiB;
constexpr size_t WKV_W1V = 16 * MiB;
constexpr size_t WKV_BIASK = 20 * MiB;
constexpr size_t WKV_BIASV = 20 * MiB + 4096;
constexpr size_t WKV_BPART = 20 * MiB + 512 * 1024;
constexpr size_t WKV_W2K = 20 * MiB + 64 * 1024, WKV_W2V = 20 * MiB + 192 * 1024;
constexpr size_t WKV_ROPE = 21 * MiB;
constexpr size_t SKV_T = 16 * MiB;
constexpr size_t SKV_KCMP = 96 * MiB, SKV_VCMP = 97 * MiB;
constexpr size_t AUX_SK = 0;
constexpr size_t AUX_G = 3 * MiB, AUX_BETA = 4 * MiB;
constexpr size_t AUX_RL = 5 * MiB;
constexpr size_t AUX_TOKE = AUX_RL + 512 * 1024, AUX_TOKR = AUX_TOKE + 128 * 1024, AUX_TOKW = AUX_TOKR + 128 * 1024, AUX_SLOTOF = AUX_TOKW + 128 * 1024;
constexpr size_t AUX_ROWW = 6 * MiB;
constexpr size_t AUX_HK = 8 * MiB, AUX_HV = 12 * MiB;
constexpr int CW_BAR = 0;
constexpr int CW_MOECNT = 4096;
constexpr int CW_TILEE = 4352;
constexpr int CTL_ZERO_BYTES = 32768;
static_assert(WB_ROUTER + 256 * 1024 <= 234 * MiB, "wb");

#define MFMA32(a, b, c) __builtin_amdgcn_mfma_f32_32x32x16_bf16((a), (b), (c), 0, 0, 0)
#define MFMA16(a, b, c) __builtin_amdgcn_mfma_f32_16x16x32_bf16((a), (b), (c), 0, 0, 0)
DI float bf2f(bf16_t v) { return __uint_as_float(((unsigned)v) << 16); }
DI unsigned pack2(float lo, float hi) { bfx2_t v; v.x = (__bf16)lo; v.y = (__bf16)hi; return __builtin_bit_cast(unsigned, v); }
DI bf16_t f2bf(float f) { __bf16 b = (__bf16)f; return __builtin_bit_cast(unsigned short, b); }
DI float lo2f(unsigned w) { return __uint_as_float(w << 16); }
DI float hi2f(unsigned w) { return __uint_as_float(w & 0xffff0000u); }
template <int O> DI float xor_f(float v) {
    if constexpr (O == 32) { auto r = __builtin_amdgcn_permlane32_swap(__float_as_uint(v), __float_as_uint(v), false, false); return __uint_as_float(r[0]) == v ? __uint_as_float(r[1]) : __uint_as_float(r[0]); }
    else return __uint_as_float((unsigned)__builtin_amdgcn_ds_swizzle((int)__float_as_uint(v), (O << 10) | 0x1F));
}
DI float wave_sum(float v) {
    v += xor_f<1>(v); v += xor_f<2>(v); v += xor_f<4>(v); v += xor_f<8>(v); v += xor_f<16>(v);
    { auto r = __builtin_amdgcn_permlane32_swap(__float_as_uint(v), __float_as_uint(v), false, false); v = __uint_as_float(r[0]) + __uint_as_float(r[1]); }
    return v; }
DI float wave_max(float v) {
    v = fmaxf(v, xor_f<1>(v)); v = fmaxf(v, xor_f<2>(v)); v = fmaxf(v, xor_f<4>(v)); v = fmaxf(v, xor_f<8>(v)); v = fmaxf(v, xor_f<16>(v));
    { auto r = __builtin_amdgcn_permlane32_swap(__float_as_uint(v), __float_as_uint(v), false, false); v = fmaxf(__uint_as_float(r[0]), __uint_as_float(r[1])); }
    return v; }
DI int lane_id() { int l; asm volatile("v_mbcnt_lo_u32_b32 %0, -1, 0\n\tv_mbcnt_hi_u32_b32 %0, -1, %0" : "=v"(l)); return l; }
DI float fast_sigmoid(float x) { return __builtin_amdgcn_rcpf(1.0f + __expf(-x)); }
DI float silu_f(float x) { return x * __builtin_amdgcn_rcpf(1.0f + __expf(-x)); }

#define XB_TMO      128
#define XB_XCNT(j)  (256  + 64 * (j))
#define XB_XSUB(j)  (1280 + 64 * (j))
#define XB_XGEN(j)  (2304 + 64 * (j))
#define XB_TOP      3328
#define XB_TOPGEN   3392
#define XCD_BAR_WORDS 3456
#define XB_SPIN_CAP (1u << 22)
DI unsigned xb_ld(unsigned* p)              { return __hip_atomic_load(p, __ATOMIC_RELAXED, __HIP_MEMORY_SCOPE_AGENT); }
DI unsigned xb_add(unsigned* p, unsigned v) { return __hip_atomic_fetch_add(p, v, __ATOMIC_RELAXED, __HIP_MEMORY_SCOPE_AGENT); }
DI unsigned xb_xcc_id() { return (unsigned)__builtin_amdgcn_s_getreg((3 << 11) | 20) & 0xFu; }
#define XB_SPIN(cond, bar) do { unsigned _sp = 0; while (cond) { __builtin_amdgcn_s_sleep(1); \
    if ((++_sp & 255u) == 0u) { if (xb_ld(&(bar)[XB_TMO])) break; if (_sp > XB_SPIN_CAP) { atomicAdd(&(bar)[XB_TMO], 1u); break; } } } } while (0)
struct XcdBarrier { unsigned* bar; unsigned x; volatile LAS unsigned* st; };
DI XcdBarrier xcd_barrier_post(unsigned* bar, volatile LAS unsigned* st, int tid) {
    XcdBarrier b; b.bar = bar; b.x = xb_xcc_id(); b.st = st;
    if (tid == 0) (void)xb_add(&bar[XB_XCNT(b.x)], 1u);
    return b;
}
DI void xcd_barrier_complete(unsigned* bar, unsigned x, unsigned& nloc, unsigned& nx) {
    const unsigned G = gridDim.x * gridDim.y * gridDim.z;
    unsigned sum, cnt, mine, sp = 0u;
    for (;;) {
        sum = 0u; cnt = 0u; mine = 0u;
#pragma unroll
        for (unsigned j = 0; j < 16; ++j) { const unsigned c = xb_ld(&bar[XB_XCNT(j)]); sum += c; cnt += (c > 0u) ? 1u : 0u; mine = (j == x) ? c : mine; }
        if (sum == G) break;
        __builtin_amdgcn_s_sleep(1);
        if ((++sp & 255u) == 0u) { if (xb_ld(&bar[XB_TMO])) break; if (sp > XB_SPIN_CAP) { atomicAdd(&bar[XB_TMO], 1u); break; } }
    }
    nloc = mine > 0u ? mine : 1u; nx = cnt > 0u ? cnt : 1u;
}
DI void xcd_barrier(const XcdBarrier& b, int tid) {
    asm volatile("s_waitcnt vmcnt(0)" ::: "memory");
    __syncthreads();
    if (tid == 0) {
        unsigned* bar = b.bar;
        __builtin_amdgcn_s_waitcnt(0);
        unsigned nloc = b.st[0], nx = b.st[1];
        if (nloc == 0u) { xcd_barrier_complete(bar, b.x, nloc, nx); b.st[0] = nloc; b.st[1] = nx; }
        const unsigned old = xb_add(&bar[XB_XSUB(b.x)], 1u);
        const unsigned gen = old / nloc;
        if (old + 1u == (gen + 1u) * nloc) {
            __builtin_amdgcn_fence(__ATOMIC_RELEASE, "agent");
            asm volatile("s_waitcnt vmcnt(0)" ::: "memory");
            const unsigned og = xb_add(&bar[XB_TOP], 1u);
            const unsigned tg = og / nx;
            if (og + 1u == (tg + 1u) * nx) xb_add(&bar[XB_TOPGEN], 1u);
            else XB_SPIN(xb_ld(&bar[XB_TOPGEN]) == tg, bar);
            __builtin_amdgcn_fence(__ATOMIC_ACQUIRE, "agent");
            xb_add(&bar[XB_XGEN(b.x)], 1u);
            asm volatile("s_waitcnt vmcnt(0)" ::: "memory");
        } else {
            XB_SPIN(xb_ld(&bar[XB_XGEN(b.x)]) == gen, bar);
            __builtin_amdgcn_fence(__ATOMIC_ACQUIRE, "agent");
            asm volatile("s_waitcnt vmcnt(0)" ::: "memory");
        }
    }
    __syncthreads();
}

namespace pg8 {
constexpr int BM = 256, BK = 64, HALF = 128, HTB = HALF * BK * 2, STAGE_BYTES = 8 * HTB, NXCD = 8, WGM = 8;
__host__ __device__ __forceinline__ int lds_byte(int r, int c) { const int st = (r >> 4) * 2 + (c >> 5), rr = r & 15, cc = c & 31, ob = rr * 64 + cc * 2; return st * 1024 + (ob ^ (((ob >> 9) & 1) << 5)); }
__host__ __device__ __forceinline__ void stage_rc(int b, int& R, int& C) { const int st = b / 1024, sb = b % 1024, swz = sb ^ (((sb >> 9) & 1) << 5); R = (st >> 1) * 16 + swz / 64; C = (st & 1) * 32 + (swz % 64) / 2; }
__host__ __device__ __forceinline__ int perm32(int rho) { const int n = rho >> 4, i = rho & 15; return 8 * (i >> 2) + 4 * n + (i & 3); }
struct Unit { int pm, pn, aux; const char* A; const char* B; };
struct Gemm { int K, lda, ldb; };
DI bool static_map(int i, int G, int c, int nM, int nN, int& pm, int& pn) {
    const int nwg = nM * nN; const long L = (long)i * G + c; if (L >= nwg) return false;
    int wgid = (int)L; { const int q = nwg / NXCD, r = nwg % NXCD, xcd = wgid % NXCD, off = wgid / NXCD; wgid = (xcd < r ? xcd * (q + 1) : r * (q + 1) + (xcd - r) * q) + off; }
    const int nig = WGM * nN, gid = wgid / nig, fm = gid * WGM, gsz = (nM - fm) < WGM ? (nM - fm) : WGM;
    pm = fm + ((wgid % nig) % gsz); pn = (wgid % nig) / gsz; return true;
}
struct SchedDense {
    int nM, nN, G, c; const char* A; const char* B; size_t astep, bstep;
    DI void init(int M, int N, int G_, int c_, const void* A_, int lda, const void* B_, int ldb) { nM = M / BM; nN = N / BM; G = G_; c = c_; A = (const char*)A_; B = (const char*)B_; astep = (size_t)BM * lda * 2; bstep = (size_t)BM * ldb * 2; }
    DI bool next(int i, Unit& u) const { if (!static_map(i, G, c, nM, nN, u.pm, u.pn)) return false; u.aux = 0; u.A = A + (size_t)u.pm * astep; u.B = B + (size_t)u.pn * bstep; return true; }
    DI void a_ready(const Unit&) const {}
    DI void done(const Unit&) const {}
};
struct SchedMoe {
    int nM, nN, G, c; const char* A; const char* B; size_t astep, bstep, estep; const int* tile_e;
    DI bool next(int i, Unit& u) const { if (!static_map(i, G, c, nM, nN, u.pm, u.pn)) return false; u.aux = tile_e[u.pm]; u.A = A + (size_t)u.pm * astep; u.B = B + (size_t)u.aux * estep + (size_t)u.pn * bstep; return true; }
    DI void a_ready(const Unit&) const {}
    DI void done(const Unit&) const {}
};
DI void static_map_L(int L, int nM, int nN, int& pm, int& pn) {
    const int nwg = nM * nN; int wgid = L; { const int q = nwg / NXCD, r = nwg % NXCD, xcd = wgid % NXCD, off = wgid / NXCD; wgid = (xcd < r ? xcd * (q + 1) : r * (q + 1) + (xcd - r) * q) + off; }
    const int nig = WGM * nN, gid = wgid / nig, fm = gid * WGM, gsz = (nM - fm) < WGM ? (nM - fm) : WGM;
    pm = fm + ((wgid % nig) % gsz); pn = (wgid % nig) / gsz;
}
struct SchedMoe2 {
    int g0, g1, d0, d1, G, c; const char* Ag; const char* Bg; const char* Ad; const char* Bd; const int* tile_e;
    DI bool next(int i, Unit& u) const {
        const int NG = (g1 - g0) * 16, ND = (d1 - d0) * 8; const int L = i * G + c; if (L >= NG + ND) return false;
        if (L < NG) { static_map_L(L, g1 - g0, 16, u.pm, u.pn); u.pm += g0; const int e = tile_e[u.pm]; u.aux = e;
            u.A = Ag + (size_t)u.pm * 256 * 2048 * 2; u.B = Bg + (size_t)e * 4096 * 2048 * 2 + (size_t)u.pn * 256 * 2048 * 2; }
        else { static_map_L(L - NG, d1 - d0, 8, u.pm, u.pn); u.pm += d0; const int e = tile_e[u.pm]; u.aux = e | 256;
            u.A = Ad + (size_t)u.pm * 256 * 2048 * 2; u.B = Bd + (size_t)e * 2048 * 2048 * 2 + (size_t)u.pn * 256 * 2048 * 2; }
        return true; }
    DI void a_ready(const Unit&) const {}
    DI void done(const Unit&) const {}
};
struct SchedCmp {
    int G, c; const char* A0; const char* A1; const char* B0; const char* B1;
    DI bool next(int i, Unit& u) const { const int L = i * G + c; if (L >= 256) return false; const int p = L >> 7, ks = (L >> 5) & 3, r = L & 31; u.aux = p * 4 + ks; u.pm = r & 15; u.pn = r >> 4;
        u.A = (p ? A1 : A0) + (size_t)u.pm * 256 * 2048 * 2 + (size_t)ks * 1024 * 2; u.B = (p ? B1 : B0) + (size_t)u.pn * 256 * 4096 * 2 + (size_t)ks * 1024 * 2; return true; }
    DI void a_ready(const Unit&) const {}
    DI void done(const Unit&) const {}
};

typedef f32x4 Acc[2][2][4][2];
struct EpiRes {
    static constexpr bool PERM = true;
    const void* base; bf16_t* out; int ldc; bool base_f32;
    DI void operator()(const Acc& acc, const Unit& u, int wr, int wc, int fr, int fq) const {
        const int row0 = u.pm * BM + wr * 64 + fr, col0 = u.pn * BM + wc * 32 + 8 * fq;
#pragma unroll
        for (int ai = 0; ai < 2; ++ai)
#pragma unroll
            for (int m = 0; m < 4; ++m) { const size_t off = (size_t)(row0 + ai * HALF + m * 16) * ldc + col0;
#pragma unroll
                for (int bj = 0; bj < 2; ++bj) { const size_t o = off + bj * HALF; f32x4 b0, b1;
                    if (base_f32) { b0 = *(const f32x4*)((const float*)base + o); b1 = *(const f32x4*)((const float*)base + o + 4); }
                    else { const u32x4 w = *(const u32x4*)((const bf16_t*)base + o); b0 = (f32x4){lo2f(w.x), hi2f(w.x), lo2f(w.y), hi2f(w.y)}; b1 = (f32x4){lo2f(w.z), hi2f(w.z), lo2f(w.w), hi2f(w.w)}; }
                    const f32x4 v0 = acc[ai][bj][m][0] + b0, v1 = acc[ai][bj][m][1] + b1;
                    u32x4 w; w.x = pack2(v0[0], v0[1]); w.y = pack2(v0[2], v0[3]); w.z = pack2(v1[0], v1[1]); w.w = pack2(v1[2], v1[3]);
                    *(u32x4*)(out + o) = w; } }
    }
};
struct EpiScaleRows {
    static constexpr bool PERM = true;
    bf16_t* out; int ldc; const float* roww;
    DI void operator()(const Acc& acc, const Unit& u, int wr, int wc, int fr, int fq) const {
        const int row0 = u.pm * BM + wr * 64 + fr, col0 = u.pn * BM + wc * 32 + 8 * fq;
#pragma unroll
        for (int ai = 0; ai < 2; ++ai)
#pragma unroll
            for (int m = 0; m < 4; ++m) { const int row = row0 + ai * HALF + m * 16; const float sw = roww[row]; const size_t off = (size_t)row * ldc + col0;
#pragma unroll
                for (int bj = 0; bj < 2; ++bj) { const f32x4 v0 = acc[ai][bj][m][0] * sw, v1 = acc[ai][bj][m][1] * sw;
                    u32x4 w; w.x = pack2(v0[0], v0[1]); w.y = pack2(v0[2], v0[3]); w.z = pack2(v1[0], v1[1]); w.w = pack2(v1[2], v1[3]);
                    *(u32x4*)(out + off + bj * HALF) = w; } }
    }
};
struct EpiSplit {
    static constexpr bool PERM = true;
    bf16_t* O; int ldc; int split_cols; size_t split_stride;
    DI void operator()(const Acc& acc, const Unit& u, int wr, int wc, int fr, int fq) const {
        const int row0 = u.pm * BM + wr * 64 + fr; int colt = u.pn * BM; bf16_t* base = O;
        { const int t = colt / split_cols; base += (size_t)t * split_stride; colt -= t * split_cols; }
        const int col0 = colt + wc * 32 + 8 * fq;
#pragma unroll
        for (int ai = 0; ai < 2; ++ai)
#pragma unroll
            for (int m = 0; m < 4; ++m) { bf16_t* rowp = base + (size_t)(row0 + ai * HALF + m * 16) * ldc + col0;
#pragma unroll
                for (int bj = 0; bj < 2; ++bj) { const f32x4 v0 = acc[ai][bj][m][0], v1 = acc[ai][bj][m][1];
                    u32x4 w; w.x = pack2(v0[0], v0[1]); w.y = pack2(v0[2], v0[3]); w.z = pack2(v1[0], v1[1]); w.w = pack2(v1[2], v1[3]);
                    *(u32x4*)(rowp + bj * HALF) = w; } }
    }
};
struct EpiSwiglu {
    static constexpr bool PERM = true;
    bf16_t* O; int ldc;
    DI void operator()(const Acc& acc, const Unit& u, int wr, int wc, int fr, int fq) const {
        const int row0 = u.pm * BM + wr * 64 + fr, col0 = u.pn * HALF + wc * 32 + 8 * fq;
#pragma unroll
        for (int ai = 0; ai < 2; ++ai)
#pragma unroll
            for (int m = 0; m < 4; ++m) { bf16_t* rowp = O + (size_t)(row0 + ai * HALF + m * 16) * ldc + col0;
                float r[8];
#pragma unroll
                for (int n = 0; n < 2; ++n)
#pragma unroll
                    for (int j = 0; j < 4; ++j) { const float g = acc[ai][0][m][n][j], uu = acc[ai][1][m][n][j]; r[n * 4 + j] = silu_f(g) * uu; }
                u32x4 w; w.x = pack2(r[0], r[1]); w.y = pack2(r[2], r[3]); w.z = pack2(r[4], r[5]); w.w = pack2(r[6], r[7]);
                *(u32x4*)rowp = w; }
    }
};
struct EpiMoe {
    static constexpr bool PERM = true;
    bf16_t* act; bf16_t* y; const float* roww;
    DI void operator()(const Acc& acc, const Unit& u, int wr, int wc, int fr, int fq) const {
        if (u.aux & 256) { EpiScaleRows E{y, 2048, roww}; E(acc, u, wr, wc, fr, fq); }
        else { EpiSwiglu E{act, 2048}; E(acc, u, wr, wc, fr, fq); }
    }
};
struct EpiHeads {
    static constexpr bool PERM = true;
    bf16_t* O; int hpt; size_t tstride; unsigned rope_mask; bf16_t* O2; const float* ctab; const float* stab;
    DI void operator()(const Acc& acc, const Unit& u, int wr, int wc, int fr, int fq) const {
        const int row0 = u.pm * BM + wr * 64 + fr, d0 = wc * 32 + 8 * fq;
#pragma unroll
        for (int bj = 0; bj < 2; ++bj) { const int c128 = u.pn * 2 + bj, t = c128 / hpt, hd = c128 - t * hpt; bf16_t* tb = O + (size_t)t * tstride;
            const bool rot = ((rope_mask >> t) & 1u) != 0u;
#pragma unroll
            for (int ai = 0; ai < 2; ++ai)
#pragma unroll
                for (int m = 0; m < 4; ++m) { const int row = row0 + ai * HALF + m * 16, b = row >> 11, s = row & 2047;
                    const size_t po = ((size_t)(b * hpt + hd) * 2048 + s) * 128 + d0; const f32x4 v0 = acc[ai][bj][m][0], v1 = acc[ai][bj][m][1];
                    u32x4 w; w.x = pack2(v0[0], v0[1]); w.y = pack2(v0[2], v0[3]); w.z = pack2(v1[0], v1[1]); w.w = pack2(v1[2], v1[3]);
                    u32x4 wr_ = w;
                    if (rot && wc == 0) {
                        const int j0 = 8 * (fq & 1); const float sgn = (fq & 2) ? 1.f : -1.f;
                        const f32x4 ca = *(const f32x4*)(ctab + (size_t)row * 16 + j0), cb = *(const f32x4*)(ctab + (size_t)row * 16 + j0 + 4);
                        const f32x4 sa = *(const f32x4*)(stab + (size_t)row * 16 + j0), sb = *(const f32x4*)(stab + (size_t)row * 16 + j0 + 4);
                        float o[8];
#pragma unroll
                        for (int e = 0; e < 4; ++e) {
                            const float pa = xor_f<32>(v0[e]), pb = xor_f<32>(v1[e]);
                            o[e] = v0[e] * ca[e] + sgn * pa * sa[e]; o[4 + e] = v1[e] * cb[e] + sgn * pb * sb[e]; }
                        wr_.x = pack2(o[0], o[1]); wr_.y = pack2(o[2], o[3]); wr_.z = pack2(o[4], o[5]); wr_.w = pack2(o[6], o[7]);
                    }
                    if (O2) { *(u32x4*)(tb + po) = w; *(u32x4*)(O2 + po) = wr_; } else *(u32x4*)(tb + po) = wr_; } }
    }
};
struct EpiCmp {
    static constexpr bool PERM = false;
    float* part;
    DI void operator()(const Acc& acc, const Unit& u, int wr, int wc, int fr, int fq) const {
        float* O = part + (size_t)u.aux * 4096 * 512;
        const int row0 = u.pm * BM + wr * 64 + fr, col0 = u.pn * BM + wc * 32 + 4 * fq;
#pragma unroll
        for (int ai = 0; ai < 2; ++ai)
#pragma unroll
            for (int m = 0; m < 4; ++m) { const size_t off = (size_t)(row0 + ai * HALF + m * 16) * 512 + col0;
#pragma unroll
                for (int bj = 0; bj < 2; ++bj)
#pragma unroll
                    for (int n = 0; n < 2; ++n) *(f32x4*)(O + off + bj * HALF + n * 16) = acc[ai][bj][m][n]; }
    }
};

template <class E> DI void epi_prefetch(const E&, const Unit&, int, unsigned&, unsigned&) {}
DI void epi_prefetch(const EpiRes& E, const Unit& u, int tid, unsigned& p0, unsigned& p1) {
    if (E.base_f32) return;
    const bf16_t* b = (const bf16_t*)E.base + (size_t)(u.pm * BM + (tid >> 1)) * E.ldc + u.pn * BM + (tid & 1) * 128;
    asm volatile("global_load_dword %0, %2, off\n\tglobal_load_dword %1, %2, off offset:128" : "=&v"(p0), "=&v"(p1) : "v"(b) : "memory");
}
template <class Epi, class Sched>
DI void gemm_phase(LAS unsigned char* lds, const Gemm g, const Sched& S, const Epi& E, int tid_in) {
    int tid_ = tid_in; asm volatile("" : "+v"(tid_));
    const int tid = tid_, wid = __builtin_amdgcn_readfirstlane(tid >> 6), lane = tid & 63, wr = wid >> 2, wc = wid & 3, fr = lane & 15, fq = lane >> 4;
    const int K = g.K, nt = K / BK;
    unsigned voffA[2], voffB[2];
#pragma unroll
    for (int i = 0; i < 2; ++i) { int R, C; stage_rc(tid * 16 + i * 8192, R, C); const int Rb = Epi::PERM ? ((R & ~31) + perm32(R & 31)) : R;
        voffA[i] = (unsigned)(R * g.lda + C) * 2u; voffB[i] = (unsigned)(Rb * g.ldb + C) * 2u; }
    const size_t kstep = (size_t)(BK * 2);
    const size_t hstepA = (size_t)HALF * g.lda * 2, hstepB = (size_t)HALF * g.ldb * 2;
    const unsigned ldsw = (unsigned)wid * 1024u;
    const int aoff = lds_byte(wr * 64 + fr, fq * 8), boff = lds_byte(wc * 32 + fr, fq * 8);
#define PG8_SA(b, h) (((b) * 2 + (h)) * HTB)
#define PG8_SB(b, h) ((4 + (b) * 2 + (h)) * HTB)
#define PG8_STAGE(bufoff, gbase, voff) do { _Pragma("unroll") for (int _i = 0; _i < 2; ++_i) \
        __builtin_amdgcn_global_load_lds((const unsigned*)((const char*)(gbase) + (voff)[_i]), (LAS unsigned*)(lds + (bufoff) + ldsw + _i * 8192), 16, 0, 0); } while (0)
#define PG8_LDA(dst, b, h) do { _Pragma("unroll") for (int m = 0; m < 4; ++m) _Pragma("unroll") for (int k = 0; k < 2; ++k) dst[m][k] = *(const LAS bf16x8*)(lds + PG8_SA(b, h) + aoff + m * 2048 + k * 1024); } while (0)
#define PG8_LDB(dst, b, h) do { _Pragma("unroll") for (int n = 0; n < 2; ++n) _Pragma("unroll") for (int k = 0; k < 2; ++k) dst[n][k] = *(const LAS bf16x8*)(lds + PG8_SB(b, h) + boff + n * 2048 + k * 1024); } while (0)
#define PG8_MMA(ai, bj, At, Bt) do { __builtin_amdgcn_s_setprio(1); _Pragma("unroll") for (int m = 0; m < 4; ++m) _Pragma("unroll") for (int n = 0; n < 2; ++n) _Pragma("unroll") for (int k = 0; k < 2; ++k) \
        acc[ai][bj][m][n] = __builtin_amdgcn_mfma_f32_16x16x32_bf16(Bt[n][k], At[m][k], acc[ai][bj][m][n], 0, 0, 0); __builtin_amdgcn_s_setprio(0); } while (0)
#define PG8_WAIT_V(n) asm volatile("s_waitcnt vmcnt(" #n ")" ::: "memory")
#define PG8_WAIT_L(n) asm volatile("s_waitcnt lgkmcnt(" #n ")" ::: "memory")
#define PG8_BAR __builtin_amdgcn_s_barrier()
#define PG8_SCHED __builtin_amdgcn_sched_barrier(0)
    Unit cur, nxt; int ui = 0;
    if (!S.next(0, cur)) return;
    f32x4 acc[2][2][4][2];
#pragma unroll
    for (int a = 0; a < 2; ++a)
#pragma unroll
        for (int b = 0; b < 2; ++b)
#pragma unroll
            for (int m = 0; m < 4; ++m)
#pragma unroll
                for (int n = 0; n < 2; ++n) acc[a][b][m][n] = (f32x4){0.f, 0.f, 0.f, 0.f};
    bf16x8 At[4][2], B0[2][2], B1[2][2];
    unsigned pf0 = 0u, pf1 = 0u;
    const char* cA = cur.A; const char* cB = cur.B;
    S.a_ready(cur);
    PG8_STAGE(PG8_SB(0, 0), cB, voffB); PG8_STAGE(PG8_SA(0, 0), cA, voffA); PG8_STAGE(PG8_SB(0, 1), cB + hstepB, voffB); PG8_STAGE(PG8_SA(0, 1), cA + hstepA, voffA);
    if (wr == 1) PG8_BAR;
    PG8_WAIT_V(4); PG8_BAR;
    PG8_STAGE(PG8_SB(1, 0), cB + kstep, voffB); PG8_STAGE(PG8_SA(1, 0), cA + kstep, voffA); PG8_STAGE(PG8_SB(1, 1), cB + hstepB + kstep, voffB);
    PG8_WAIT_V(6); PG8_BAR;
    for (;;) {
        const bool has_next = S.next(ui + 1, nxt);
        const char* nA = has_next ? nxt.A : cA; const char* nB = has_next ? nxt.B : cB;
        for (int t = 0; t < nt; t += 2) {
            const bool last = (t == nt - 2);
            const char* a1 = cA + (size_t)(t + 1) * kstep;
            const char* a2 = last ? nA : cA + (size_t)(t + 2) * kstep; const char* b2 = last ? nB : cB + (size_t)(t + 2) * kstep;
            const char* a3 = a2 + kstep; const char* b3 = b2 + kstep;
            if (last && has_next) S.a_ready(nxt);
            PG8_LDB(B0, 0, 0); PG8_SCHED; PG8_LDA(At, 0, 0); PG8_STAGE(PG8_SA(1, 1), a1 + hstepA, voffA);
            PG8_WAIT_L(8); PG8_BAR; PG8_WAIT_L(0); PG8_MMA(0, 0, At, B0); PG8_BAR; PG8_SCHED;
            PG8_LDB(B1, 0, 1); PG8_STAGE(PG8_SB(0, 0), b2, voffB);
            PG8_BAR; PG8_WAIT_L(0); PG8_MMA(0, 1, At, B1); PG8_BAR;
            PG8_LDA(At, 0, 1); PG8_STAGE(PG8_SA(0, 0), a2, voffA);
            PG8_BAR; PG8_WAIT_L(0); PG8_MMA(1, 0, At, B0); PG8_BAR; PG8_SCHED;
            PG8_STAGE(PG8_SB(0, 1), b2 + hstepB, voffB);
            PG8_WAIT_V(6); if (last) epi_prefetch(E, cur, tid, pf0, pf1);
            PG8_BAR; PG8_MMA(1, 1, At, B1); PG8_BAR;
            PG8_LDB(B0, 1, 0); PG8_SCHED; PG8_LDA(At, 1, 0); PG8_STAGE(PG8_SA(0, 1), a2 + hstepA, voffA);
            PG8_WAIT_L(8); PG8_BAR; PG8_WAIT_L(0); PG8_MMA(0, 0, At, B0); PG8_BAR; PG8_SCHED;
            PG8_LDB(B1, 1, 1); PG8_STAGE(PG8_SB(1, 0), b3, voffB);
            PG8_BAR; PG8_WAIT_L(0); PG8_MMA(0, 1, At, B1); PG8_BAR;
            PG8_LDA(At, 1, 1); PG8_STAGE(PG8_SA(1, 0), a3, voffA);
            PG8_BAR; PG8_WAIT_L(0); PG8_MMA(1, 0, At, B0); PG8_BAR; PG8_SCHED;
            PG8_STAGE(PG8_SB(1, 1), b3 + hstepB, voffB);
            PG8_WAIT_V(6); PG8_BAR; PG8_MMA(1, 1, At, B1); PG8_BAR;
        }
        E(acc, cur, wr, wc, fr, fq); S.done(cur);
        asm volatile("" :: "v"(pf0), "v"(pf1));
        if (!has_next) break;
#pragma unroll
        for (int a = 0; a < 2; ++a)
#pragma unroll
            for (int b = 0; b < 2; ++b)
#pragma unroll
                for (int m = 0; m < 4; ++m)
#pragma unroll
                    for (int n = 0; n < 2; ++n) acc[a][b][m][n] = (f32x4){0.f, 0.f, 0.f, 0.f};
        cur = nxt; cA = nA; cB = nB; ++ui;
    }
    PG8_WAIT_V(0);
    if (wr == 0) PG8_BAR;
    PG8_BAR;
#undef PG8_SA
#undef PG8_SB
#undef PG8_STAGE
#undef PG8_LDA
#undef PG8_LDB
#undef PG8_MMA
#undef PG8_WAIT_V
#undef PG8_WAIT_L
#undef PG8_BAR
#undef PG8_SCHED
}
}

struct Params {
    const float* in[28];
    float* out;
    unsigned char* ws;
    int ph_lo, ph_hi;
};
enum { I_X = 0, I_POS, I_ATTN_NORM, I_FFN_NORM, I_FINAL_NORM, I_GDN_W_IN, I_GDN_CONV, I_GDN_A_LOG, I_GDN_DT_BIAS, I_GDN_OUT_NORM, I_GDN_W_OUT, I_KV_NORM, I_NSA_W_KV,
       I_CMP_POS_K, I_CMP_W1_K, I_CMP_W2_K, I_CMP_POS_V, I_CMP_W1_V, I_CMP_W2_V, I_NSA_W_Q, I_NSA_W_O, I_FFN_W_GATE, I_FFN_W_UP, I_FFN_W_DOWN, I_MOE_ROUTER, I_MOE_W_GATE, I_MOE_W_UP, I_MOE_W_DOWN };

struct Ctx {
    unsigned char* lds; int tid, lane, wid, G, bid;
};

DI void cvt_task(const Ctx& c, int& tbase, const float* src, int ld, int K, int N, int Npad, bf16_t* dst, int mode) {
    const int ntn = Npad / 64, ntiles = (K / 256) * ntn;
    unsigned* T = (unsigned*)c.lds;
    int t = (c.bid - (tbase % c.G) + c.G) % c.G;
    for (; t < ntiles; t += c.G) {
        const int kt = t / ntn, nt = t - kt * ntn, k0 = kt * 256, n0 = nt * 64;
        const int n4 = c.tid & 15, kp = c.tid >> 4, n = n0 + 4 * n4;
        f32x4 a[4], b[4];
#pragma unroll
        for (int it = 0; it < 4; ++it) {
            const int k = k0 + 2 * (kp + 32 * it);
            a[it] = (f32x4){0.f, 0.f, 0.f, 0.f}; b[it] = a[it];
            if (n < N) { a[it] = *(const f32x4*)(src + (size_t)k * ld + n); b[it] = *(const f32x4*)(src + (size_t)(k + 1) * ld + n); }
        }
#pragma unroll
        for (int it = 0; it < 4; ++it)
#pragma unroll
            for (int i = 0; i < 4; ++i) T[(4 * n4 + i) * 129 + kp + 32 * it] = pack2(a[it][i], b[it][i]);
        __syncthreads();
        int rbase = n0;
        if (mode) rbase = (n0 >> 7) * 256 + (n0 & 127) + (mode == 2 ? 128 : 0);
#pragma unroll
        for (int j = 0; j < 4; ++j) {
            const int ch = c.tid + 512 * j, row = ch >> 5, cc = ch & 31;
            u32x4 w; w.x = T[row * 129 + 4 * cc]; w.y = T[row * 129 + 4 * cc + 1]; w.z = T[row * 129 + 4 * cc + 2]; w.w = T[row * 129 + 4 * cc + 3];
            *(u32x4*)(dst + (size_t)(rbase + row) * K + k0 + 8 * cc) = w;
        }
        __syncthreads();
    }
    tbase += ntiles;
}

template <bool SRC_F32, int RB>
DI void norm_phase(const Ctx& c, const void* src, const bf16_t* y, const int* slot_of, bf16_t* hwb, const float* w1, bf16_t* out1, const float* w2, bf16_t* out2, float* outf) {
    for (int chunk = c.bid; chunk < M_TOK / 64; chunk += c.G)
#pragma unroll 1
    for (int kk = 0; kk < 8; kk += RB) {
        const int row0 = chunk * 64 + c.wid * 8 + kk;
        float x[RB][4][8];
        if constexpr (SRC_F32) {
#pragma unroll
            for (int r = 0; r < RB; ++r) { const float* p = (const float*)src + (size_t)(row0 + r) * DM;
#pragma unroll
                for (int i = 0; i < 4; ++i) { const f32x4 a = *(const f32x4*)(p + 8 * (c.lane + 64 * i)), b = *(const f32x4*)(p + 8 * (c.lane + 64 * i) + 4);
                    x[r][i][0] = a[0]; x[r][i][1] = a[1]; x[r][i][2] = a[2]; x[r][i][3] = a[3]; x[r][i][4] = b[0]; x[r][i][5] = b[1]; x[r][i][6] = b[2]; x[r][i][7] = b[3]; } }
        } else {
            u32x4 raw[RB][4];
#pragma unroll
            for (int r = 0; r < RB; ++r) { const bf16_t* p = (const bf16_t*)src + (size_t)(row0 + r) * DM;
#pragma unroll
                for (int i = 0; i < 4; ++i) raw[r][i] = *(const u32x4*)(p + 8 * (c.lane + 64 * i)); }
#pragma unroll
            for (int r = 0; r < RB; ++r)
#pragma unroll
                for (int i = 0; i < 4; ++i) { const u32x4 w = raw[r][i];
                    x[r][i][0] = lo2f(w.x); x[r][i][1] = hi2f(w.x); x[r][i][2] = lo2f(w.y); x[r][i][3] = hi2f(w.y); x[r][i][4] = lo2f(w.z); x[r][i][5] = hi2f(w.z); x[r][i][6] = lo2f(w.w); x[r][i][7] = hi2f(w.w); }
        }
        if (y) {
            int s0[RB], s1[RB];
#pragma unroll
            for (int r = 0; r < RB; ++r) { s0[r] = slot_of[(row0 + r) * 2]; s1[r] = slot_of[(row0 + r) * 2 + 1]; }
#pragma unroll
            for (int r = 0; r < RB; ++r) {
                const bf16_t* y0 = y + (size_t)s0[r] * DM; const bf16_t* y1 = y + (size_t)s1[r] * DM;
#pragma unroll
                for (int i = 0; i < 4; ++i) { const u32x4 a = *(const u32x4*)(y0 + 8 * (c.lane + 64 * i)), b = *(const u32x4*)(y1 + 8 * (c.lane + 64 * i));
                    x[r][i][0] += lo2f(a.x) + lo2f(b.x); x[r][i][1] += hi2f(a.x) + hi2f(b.x); x[r][i][2] += lo2f(a.y) + lo2f(b.y); x[r][i][3] += hi2f(a.y) + hi2f(b.y);
                    x[r][i][4] += lo2f(a.z) + lo2f(b.z); x[r][i][5] += hi2f(a.z) + hi2f(b.z); x[r][i][6] += lo2f(a.w) + lo2f(b.w); x[r][i][7] += hi2f(a.w) + hi2f(b.w); }
                if (hwb) {
#pragma unroll
                    for (int i = 0; i < 4; ++i) { u32x4 w; w.x = pack2(x[r][i][0], x[r][i][1]); w.y = pack2(x[r][i][2], x[r][i][3]); w.z = pack2(x[r][i][4], x[r][i][5]); w.w = pack2(x[r][i][6], x[r][i][7]);
                        *(u32x4*)(hwb + (size_t)(row0 + r) * DM + 8 * (c.lane + 64 * i)) = w;
                        x[r][i][0] = lo2f(w.x); x[r][i][1] = hi2f(w.x); x[r][i][2] = lo2f(w.y); x[r][i][3] = hi2f(w.y); x[r][i][4] = lo2f(w.z); x[r][i][5] = hi2f(w.z); x[r][i][6] = lo2f(w.w); x[r][i][7] = hi2f(w.w); }
                }
            }
        }
        float rs[RB];
#pragma unroll
        for (int r = 0; r < RB; ++r) { float ss = 0.f;
#pragma unroll
            for (int i = 0; i < 4; ++i)
#pragma unroll
                for (int e = 0; e < 8; ++e) ss += x[r][i][e] * x[r][i][e];
            rs[r] = ss; }
#pragma unroll
        for (int r = 0; r < RB; ++r) rs[r] = rsqrtf(wave_sum(rs[r]) * (1.0f / DM) + NORM_EPS);
#pragma unroll
        for (int i = 0; i < 4; ++i) {
            const int col = 8 * (c.lane + 64 * i);
            const f32x4 wa = *(const f32x4*)(w1 + col), wb = *(const f32x4*)(w1 + col + 4);
            f32x4 va = wa, vb = wb;
            if (out2) { va = *(const f32x4*)(w2 + col); vb = *(const f32x4*)(w2 + col + 4); }
#pragma unroll
            for (int r = 0; r < RB; ++r) {
                const size_t ro = (size_t)(row0 + r) * DM + col;
                float o[8];
#pragma unroll
                for (int e = 0; e < 4; ++e) { o[e] = x[r][i][e] * rs[r] * wa[e]; o[4 + e] = x[r][i][4 + e] * rs[r] * wb[e]; }
                if (outf) { *(f32x4*)(outf + ro) = (f32x4){o[0], o[1], o[2], o[3]}; *(f32x4*)(outf + ro + 4) = (f32x4){o[4], o[5], o[6], o[7]}; }
                else { u32x4 w; w.x = pack2(o[0], o[1]); w.y = pack2(o[2], o[3]); w.z = pack2(o[4], o[5]); w.w = pack2(o[6], o[7]); *(u32x4*)(out1 + ro) = w; }
                if (out2) { u32x4 w;
                    w.x = pack2(x[r][i][0] * rs[r] * va[0], x[r][i][1] * rs[r] * va[1]); w.y = pack2(x[r][i][2] * rs[r] * va[2], x[r][i][3] * rs[r] * va[3]);
                    w.z = pack2(x[r][i][4] * rs[r] * vb[0], x[r][i][5] * rs[r] * vb[1]); w.w = pack2(x[r][i][6] * rs[r] * vb[2], x[r][i][7] * rs[r] * vb[3]);
                    *(u32x4*)(out2 + ro) = w; }
            }
        }
    }
}

template <int NT>
DI void skinny_phase(const Ctx& c, const bf16_t* A, const bf16_t* Wt, float* out, int ldo, int NS) {
    float* red = (float*)c.lds;
    for (int chunk = c.bid; chunk < M_TOK / 64; chunk += c.G) {
        const int lane = lane_id(), m = lane & 15, g = lane >> 4;
        const int r0 = chunk * 64, k0 = 256 * c.wid;
        const bf16_t* ap = A + (size_t)(r0 + m) * DM + k0 + 8 * g;
        const bf16_t* bp = Wt + (size_t)m * DM + k0 + 8 * g;
        f32x4 acc[4][NT];
#pragma unroll
        for (int mt = 0; mt < 4; ++mt)
#pragma unroll
            for (int nt = 0; nt < NT; ++nt) acc[mt][nt] = (f32x4){0.f, 0.f, 0.f, 0.f};
#pragma unroll
        for (int bt = 0; bt < 4; ++bt) {
            bf16x8 af[2][4], bfr[2][NT];
#pragma unroll
            for (int s = 0; s < 2; ++s) {
#pragma unroll
                for (int mt = 0; mt < 4; ++mt) af[s][mt] = *(const bf16x8*)(ap + (size_t)(16 * mt) * DM + 32 * (2 * bt + s));
#pragma unroll
                for (int nt = 0; nt < NT; ++nt) bfr[s][nt] = *(const bf16x8*)(bp + (size_t)(16 * nt) * DM + 32 * (2 * bt + s));
            }
#pragma unroll
            for (int s = 0; s < 2; ++s)
#pragma unroll
                for (int mt = 0; mt < 4; ++mt)
#pragma unroll
                    for (int nt = 0; nt < NT; ++nt) acc[mt][nt] = MFMA16(af[s][mt], bfr[s][nt], acc[mt][nt]);
        }
        __syncthreads();
#pragma unroll
        for (int mt = 0; mt < 4; ++mt)
#pragma unroll
            for (int nt = 0; nt < NT; ++nt) *(f32x4*)(red + ((size_t)((c.wid * 4 + mt) * NT + nt) * 64 + lane) * 4) = acc[mt][nt];
        __syncthreads();
        for (int o = c.tid; o < 64 * 16 * NT; o += NTHREADS) {
            const int col = o % (16 * NT), row = o / (16 * NT), mt = row >> 4, gg = (row >> 2) & 3, r = row & 3, nt = col >> 4, mm = col & 15;
            float sum = 0.f;
#pragma unroll
            for (int w = 0; w < 8; ++w) sum += red[((size_t)((w * 4 + mt) * NT + nt) * 64 + 16 * gg + mm) * 4 + r];
            if (col < NS) out[(size_t)(r0 + row) * ldo + col] = sum;
        }
    }
}

DI void rope_table_phase(const Ctx& c, const int* pos, float* ctab, float* stab) {
    for (int i = c.bid * NTHREADS + c.tid; i < M_TOK * 16; i += c.G * NTHREADS) {
        const int tok = i >> 4, j = i & 15;
        const float inv = exp2f(-(float)j * (18.931568569324174f / 16.0f));
        const float ang = (float)pos[tok] * inv;
        float rev = ang * 0.15915494309189535f; rev -= floorf(rev);
        ctab[i] = __builtin_amdgcn_cosf(rev); stab[i] = __builtin_amdgcn_sinf(rev);
    }
}
DI void cmp_bias_phase(const Ctx& c, const float* posk, const float* w1k, const float* posv, const float* w1v, float* part) {
    for (int sl = c.bid; sl < 256; sl += c.G) {
        const int pr = sl & 1, j = sl >> 1; const float* pos = pr ? posv : posk; const float* w1 = pr ? w1v : w1k;
        float sm = 0.f;
#pragma unroll 8
        for (int k = 32 * j; k < 32 * j + 32; ++k) sm += pos[k] * w1[(size_t)k * 512 + c.tid];
        part[(size_t)(pr * 128 + j) * 512 + c.tid] = sm;
    }
}
DI void cmp_bias_reduce(const Ctx& c, const float* part, float* bk, float* bv) {
    if (c.bid < 2) { float sm = 0.f;
        for (int j = 0; j < 128; ++j) sm += part[(size_t)(c.bid * 128 + j) * 512 + c.tid];
        (c.bid ? bv : bk)[c.tid] = sm; }
}

template <int CTRL> DI float dpp_mov(float v) { return __uint_as_float((unsigned)__builtin_amdgcn_update_dpp(0, (int)__float_as_uint(v), CTRL, 0xf, 0xf, true)); }
DI float wave_sum_dpp(float v) {
    v += dpp_mov<0xB1>(v);
    v += dpp_mov<0x4E>(v);
    v += dpp_mov<0x141>(v);
    v += dpp_mov<0x140>(v);
    const int u = (int)__float_as_uint(v);
    return (__uint_as_float((unsigned)__builtin_amdgcn_readlane(u, 0)) + __uint_as_float((unsigned)__builtin_amdgcn_readlane(u, 16)))
         + (__uint_as_float((unsigned)__builtin_amdgcn_readlane(u, 32)) + __uint_as_float((unsigned)__builtin_amdgcn_readlane(u, 48)));
}
DI void gdn_conv2_phase(const Ctx& c, const bf16_t* Pq, const bf16_t* Pk, const bf16_t* Pv, const float* convw, const float* ba,
                        const float* a_log, const float* dt_bias, bf16_t* Qn, bf16_t* Kn, bf16_t* KT, bf16_t* VT, float* Gc, float* Bb) {
    const int gw = c.bid * NWAVES + c.wid, GW = c.G * NWAVES;
    for (int u = gw; u < NB * 16 * 32; u += GW) {
        const int lane = lane_id();
        const int n = u & 31, h = (u >> 5) & 15, b = u >> 9;
        const int tok0 = b * SEQ + 64 * n;
        {
            const int tok = tok0 + lane;
            const float bl = ba[(size_t)tok * 32 + h], av = ba[(size_t)tok * 32 + 16 + h] + dt_bias[h];
            const float sp = fmaxf(av, 0.f) + log1pf(__expf(-fabsf(av)));
            float g = -__expf(a_log[h]) * sp;
#pragma unroll
            for (int o = 1; o < 64; o <<= 1) { const float t = __uint_as_float((unsigned)__builtin_amdgcn_ds_bpermute(((lane - o) & 63) << 2, (int)__float_as_uint(g))); if (lane >= o) g += t; }
            Gc[(size_t)tok * 16 + h] = g; Bb[(size_t)tok * 16 + h] = fast_sigmoid(bl);
        }
        const int col = h * 128 + 2 * lane;
        float wq[4][2], wk[4][2], wv[4][2];
#pragma unroll
        for (int j = 0; j < 4; ++j) { const float* w = convw + (size_t)j * 6144 + col; wq[j][0] = w[0]; wq[j][1] = w[1]; wk[j][0] = w[2048]; wk[j][1] = w[2049]; wv[j][0] = w[4096]; wv[j][1] = w[4097]; }
        unsigned hq[3] = {0u, 0u, 0u}, hk[3] = {0u, 0u, 0u}, hv[3] = {0u, 0u, 0u};
#pragma unroll
        for (int i = 0; i < 3; ++i) { const int s = 64 * n - 3 + i;
            if (s >= 0) { const size_t off = (size_t)(b * SEQ + s) * DM + col; hq[i] = *(const unsigned*)(Pq + off); hk[i] = *(const unsigned*)(Pk + off); hv[i] = *(const unsigned*)(Pv + off); } }
        const size_t rowoff = (size_t)tok0 * DM + col;
        unsigned cq[8], ck[8], cv[8];
#pragma unroll
        for (int e = 0; e < 8; ++e) { const size_t off = rowoff + (size_t)e * DM; cq[e] = *(const unsigned*)(Pq + off); ck[e] = *(const unsigned*)(Pk + off); cv[e] = *(const unsigned*)(Pv + off); }
        bf16_t* kt0 = KT + (size_t)u * 8192 + (size_t)(2 * lane) * 8; bf16_t* vt0 = VT + (size_t)u * 8192 + (size_t)(2 * lane) * 8;
#pragma unroll
        for (int q8 = 0; q8 < 8; ++q8) {
            unsigned nq[8], nk[8], nv[8];
            if (q8 < 7) {
#pragma unroll
                for (int e = 0; e < 8; ++e) { const size_t off = rowoff + (size_t)(8 * (q8 + 1) + e) * DM; nq[e] = *(const unsigned*)(Pq + off); nk[e] = *(const unsigned*)(Pk + off); nv[e] = *(const unsigned*)(Pv + off); }
            }
            float q0[8], q1[8], k0[8], k1[8], v0[8], v1[8], sq[8], sk[8];
#pragma unroll
            for (int e = 0; e < 8; ++e) {
                const unsigned aq = (e >= 3) ? cq[e - 3] : hq[e], bq = (e >= 2) ? cq[e - 2] : hq[e + 1], cq_ = (e >= 1) ? cq[e - 1] : hq[e + 2], dq = cq[e];
                const unsigned ak = (e >= 3) ? ck[e - 3] : hk[e], bk = (e >= 2) ? ck[e - 2] : hk[e + 1], ck_ = (e >= 1) ? ck[e - 1] : hk[e + 2], dk = ck[e];
                const unsigned av = (e >= 3) ? cv[e - 3] : hv[e], bv = (e >= 2) ? cv[e - 2] : hv[e + 1], cv_ = (e >= 1) ? cv[e - 1] : hv[e + 2], dv = cv[e];
                float a0 = wq[0][0] * lo2f(aq) + wq[1][0] * lo2f(bq) + wq[2][0] * lo2f(cq_) + wq[3][0] * lo2f(dq);
                float a1 = wq[0][1] * hi2f(aq) + wq[1][1] * hi2f(bq) + wq[2][1] * hi2f(cq_) + wq[3][1] * hi2f(dq);
                float b0 = wk[0][0] * lo2f(ak) + wk[1][0] * lo2f(bk) + wk[2][0] * lo2f(ck_) + wk[3][0] * lo2f(dk);
                float b1 = wk[0][1] * hi2f(ak) + wk[1][1] * hi2f(bk) + wk[2][1] * hi2f(ck_) + wk[3][1] * hi2f(dk);
                float c0 = wv[0][0] * lo2f(av) + wv[1][0] * lo2f(bv) + wv[2][0] * lo2f(cv_) + wv[3][0] * lo2f(dv);
                float c1 = wv[0][1] * hi2f(av) + wv[1][1] * hi2f(bv) + wv[2][1] * hi2f(cv_) + wv[3][1] * hi2f(dv);
                q0[e] = silu_f(a0); q1[e] = silu_f(a1); k0[e] = silu_f(b0); k1[e] = silu_f(b1); v0[e] = silu_f(c0); v1[e] = silu_f(c1);
                sq[e] = q0[e] * q0[e] + q1[e] * q1[e]; sk[e] = k0[e] * k0[e] + k1[e] * k1[e];
            }
#pragma unroll
            for (int e = 0; e < 8; ++e) { sq[e] = wave_sum_dpp(sq[e]); sk[e] = wave_sum_dpp(sk[e]); }
#pragma unroll
            for (int e = 0; e < 8; ++e) {
                const float rq = rsqrtf(sq[e] + NORM_EPS) * 0.08838834764831845f, rk = rsqrtf(sk[e] + NORM_EPS);
                k0[e] *= rk; k1[e] *= rk;
                const size_t off = rowoff + (size_t)(8 * q8 + e) * DM;
                const size_t uo = (size_t)u * 8192 + (size_t)(8 * q8 + e) * 128 + 2 * lane;
                *(unsigned*)(Qn + uo) = pack2(q0[e] * rq, q1[e] * rq);
                *(unsigned*)(Kn + uo) = pack2(k0[e], k1[e]);
            }
            u32x4 w;
            w.x = pack2(k0[0], k0[1]); w.y = pack2(k0[2], k0[3]); w.z = pack2(k0[4], k0[5]); w.w = pack2(k0[6], k0[7]); *(u32x4*)(kt0 + 1024 * q8) = w;
            w.x = pack2(k1[0], k1[1]); w.y = pack2(k1[2], k1[3]); w.z = pack2(k1[4], k1[5]); w.w = pack2(k1[6], k1[7]); *(u32x4*)(kt0 + 1024 * q8 + 8) = w;
            w.x = pack2(v0[0], v0[1]); w.y = pack2(v0[2], v0[3]); w.z = pack2(v0[4], v0[5]); w.w = pack2(v0[6], v0[7]); *(u32x4*)(vt0 + 1024 * q8) = w;
            w.x = pack2(v1[0], v1[1]); w.y = pack2(v1[2], v1[3]); w.z = pack2(v1[4], v1[5]); w.w = pack2(v1[6], v1[7]); *(u32x4*)(vt0 + 1024 * q8 + 8) = w;
#pragma unroll
            for (int i = 0; i < 3; ++i) { hq[i] = cq[5 + i]; hk[i] = ck[5 + i]; hv[i] = cv[5 + i]; }
            if (q8 < 7) {
#pragma unroll
                for (int e = 0; e < 8; ++e) { cq[e] = nq[e]; ck[e] = nk[e]; cv[e] = nv[e]; }
            }
        }
    }
}

typedef float f32x16 __attribute__((ext_vector_type(16)));
DI int crow32(int r, int hi) { return (r & 3) + 8 * (r >> 2) + 4 * hi; }
DI bf16x8 pack8f(float a0, float a1, float a2, float a3, float a4, float a5, float a6, float a7) {
    u32x4 w; w.x = pack2(a0, a1); w.y = pack2(a2, a3); w.z = pack2(a4, a5); w.w = pack2(a6, a7); return __builtin_bit_cast(bf16x8, w); }

constexpr int SOLVE_LT_STRIDE = 68;
constexpr int SOLVE_WAVE_LDS = 64 * SOLVE_LT_STRIDE * 4 + 768;
DI void gdn_solve_phase(const Ctx& c, const bf16_t* Qn, const bf16_t* Kn, const bf16_t* KT, const bf16_t* VT, const float* Gc, const float* Bb,
                        bf16_t* UT, bf16_t* Wn, bf16_t* Aqk) {
    const int gw = c.bid * NWAVES + c.wid, GW = c.G * NWAVES;
    float* LT = (float*)(c.lds + c.wid * SOLVE_WAVE_LDS); float* gcl = LT + 64 * SOLVE_LT_STRIDE; float* bel = gcl + 64; float* egl = bel + 64;
    for (int u = gw; u < NB * 16 * 32; u += GW) {
        int lane_ = lane_id();
        const int lane = lane_, r32 = lane & 31, hi = lane >> 5;
        const int n = u & 31, h = (u >> 5) & 15, b = u >> 9;
        const int tok0 = b * SEQ + 64 * n;
        const float gc_l = Gc[(size_t)(tok0 + lane) * 16 + h], be_l = Bb[(size_t)(tok0 + lane) * 16 + h];
        gcl[lane] = gc_l; bel[lane] = be_l; egl[lane] = be_l * __expf(gc_l);
        bf16x8 kf[2][8];
#pragma unroll
        for (int t = 0; t < 2; ++t)
#pragma unroll
            for (int s = 0; s < 8; ++s) kf[t][s] = *(const bf16x8*)(Kn + (size_t)u * 8192 + (size_t)(32 * t + r32) * 128 + 16 * s + 8 * hi);
        __builtin_amdgcn_wave_barrier();
#pragma unroll
        for (int at = 0; at < 2; ++at)
#pragma unroll
            for (int bt = 0; bt <= at; ++bt) {
                f32x16 acc = {};
#pragma unroll
                for (int s = 0; s < 8; ++s) acc = MFMA32(kf[bt][s], kf[at][s], acc);
                const int a = 32 * at + r32; const float gca = gcl[a], bea = bel[a];
#pragma unroll
                for (int q = 0; q < 4; ++q) { const int b0 = 32 * bt + 8 * q + 4 * hi;
                    const f32x4 gb = *(const f32x4*)(gcl + b0); f32x4 o;
#pragma unroll
                    for (int e = 0; e < 4; ++e) o[e] = bea * acc[4 * q + e] * __expf(fminf(gca - gb[e], 0.f));
                    *(f32x4*)(LT + a * SOLVE_LT_STRIDE + b0) = o; }
            }
        bf16_t* aq = Aqk + (size_t)u * 4096;
#pragma unroll
        for (int it = 0; it < 2; ++it) {
            bf16x8 qf[8];
#pragma unroll
            for (int s = 0; s < 8; ++s) qf[s] = *(const bf16x8*)(Qn + (size_t)u * 8192 + (size_t)(32 * it + r32) * 128 + 16 * s + 8 * hi);
            const int i = 32 * it + r32; const float gci = gcl[i];
#pragma unroll
            for (int jt = 0; jt < 2; ++jt) {
                f32x16 acc = {};
                if (jt <= it) {
#pragma unroll
                    for (int s = 0; s < 8; ++s) acc = MFMA32(kf[jt][s], qf[s], acc);
                }
                const int lim = i - 32 * jt - 4 * hi;
#pragma unroll
                for (int q = 0; q < 4; ++q) { const int j0 = 32 * jt + 8 * q + 4 * hi; const f32x4 gj = *(const f32x4*)(gcl + j0); float o[4];
#pragma unroll
                    for (int e = 0; e < 4; ++e) o[e] = (8 * q + e <= lim) ? acc[4 * q + e] * __expf(fminf(gci - gj[e], 0.f)) : 0.f;
                    u32x2 w; w.x = pack2(o[0], o[1]); w.y = pack2(o[2], o[3]); *(u32x2*)(aq + (size_t)(j0 >> 2) * 256 + (size_t)i * 4) = w; }
            }
            asm volatile("" ::: "memory");
        }
        __builtin_amdgcn_wave_barrier();
        asm volatile("s_waitcnt lgkmcnt(0)" ::: "memory");
        float T[64];
#pragma unroll
        for (int cc = 0; cc < 64; ++cc) T[cc] = (lane == cc) ? 1.f : 0.f;
#pragma unroll
        for (int j = 63; j >= 1; --j) {
            const float tj = -T[j];
#pragma unroll
            for (int q = 0; q <= (j - 1) / 4; ++q) { const f32x4 lv = *(const f32x4*)(LT + j * SOLVE_LT_STRIDE + 4 * q);
#pragma unroll
                for (int e = 0; e < 4; ++e) { const int cc = 4 * q + e; if (cc < j) T[cc] = __builtin_fmaf(tj, lv[e], T[cc]); }
                if ((q & 7) == 7) asm volatile("" ::: "memory"); }
            asm volatile("" ::: "memory");
        }
        bf16x8 fb[2][4], fg[2][4];
#pragma unroll
        for (int s = 0; s < 4; ++s) {
            f32x4 bv[4], gv[4];
#pragma unroll
            for (int k = 0; k < 4; ++k) { bv[k] = *(const f32x4*)(bel + 16 * s + 4 * k); gv[k] = *(const f32x4*)(egl + 16 * s + 4 * k); }
            u32x4 f0, f1, g0v, g1v;
#pragma unroll
            for (int e = 0; e < 4; ++e) {
                const int j0 = 16 * s + 2 * e, j1 = j0 + 8, k0 = e >> 1, x0 = 2 * (e & 1);
                const unsigned pb0 = pack2(T[j0] * bv[k0][x0], T[j0 + 1] * bv[k0][x0 + 1]), pb1 = pack2(T[j1] * bv[2 + k0][x0], T[j1 + 1] * bv[2 + k0][x0 + 1]);
                const unsigned pg0 = pack2(T[j0] * gv[k0][x0], T[j0 + 1] * gv[k0][x0 + 1]), pg1 = pack2(T[j1] * gv[2 + k0][x0], T[j1 + 1] * gv[2 + k0][x0 + 1]);
                auto rb = __builtin_amdgcn_permlane32_swap(pb0, pb1, false, false); f0[e] = rb[0]; f1[e] = rb[1];
                auto rg = __builtin_amdgcn_permlane32_swap(pg0, pg1, false, false); g0v[e] = rg[0]; g1v[e] = rg[1];
            }
            fb[0][s] = __builtin_bit_cast(bf16x8, f0); fb[1][s] = __builtin_bit_cast(bf16x8, f1);
            fg[0][s] = __builtin_bit_cast(bf16x8, g0v); fg[1][s] = __builtin_bit_cast(bf16x8, g1v);
            asm volatile("" ::: "memory");
        }
        const bf16_t* vt = VT + (size_t)u * 8192; bf16_t* ut = UT + (size_t)u * 8192;
#pragma unroll
        for (int nt = 0; nt < 4; ++nt) {
            bf16x8 vf[4];
#pragma unroll
            for (int s = 0; s < 4; ++s) vf[s] = *(const bf16x8*)(vt + (size_t)(2 * s + hi) * 1024 + (size_t)(32 * nt + r32) * 8);
#pragma unroll
            for (int mt = 0; mt < 2; ++mt) {
                f32x16 acc = {};
#pragma unroll
                for (int s = 0; s < 4; ++s) acc = MFMA32(fb[mt][s], vf[s], acc);
#pragma unroll
                for (int q = 0; q < 4; ++q) { u32x2 w; w.x = pack2(acc[4 * q], acc[4 * q + 1]); w.y = pack2(acc[4 * q + 2], acc[4 * q + 3]);
                    *(u32x2*)(ut + (size_t)(8 * mt + 2 * q + hi) * 512 + (size_t)(32 * nt + r32) * 4) = w; }
            }
            asm volatile("" ::: "memory");
        }
        const bf16_t* kt = KT + (size_t)u * 8192; bf16_t* wn = Wn + (size_t)u * 8192;
#pragma unroll
        for (int dt = 0; dt < 4; ++dt) {
            bf16x8 kfr[4];
#pragma unroll
            for (int s = 0; s < 4; ++s) kfr[s] = *(const bf16x8*)(kt + (size_t)(2 * s + hi) * 1024 + (size_t)(32 * dt + r32) * 8);
#pragma unroll
            for (int it = 0; it < 2; ++it) {
                f32x16 acc = {};
#pragma unroll
                for (int s = 0; s < 4; ++s) acc = MFMA32(kfr[s], fg[it][s], acc);
#pragma unroll
                for (int q = 0; q < 4; ++q) { u32x2 w; w.x = pack2(-acc[4 * q], -acc[4 * q + 1]); w.y = pack2(-acc[4 * q + 2], -acc[4 * q + 3]);
                    *(u32x2*)(wn + (size_t)(8 * dt + 2 * q + hi) * 256 + (size_t)(32 * it + r32) * 4) = w; }
            }
            asm volatile("" ::: "memory");
        }
        __builtin_amdgcn_wave_barrier();
    }
}

constexpr int SC_W = 0, SC_Q = 17408, SC_K = 34816, SC_A = 53248, SC_U = 62464, SC_E = 71680, SC_BUF = 72320;
DI bf16x8 ld_frag8(const unsigned char* base, int off0, int off1) {
    const u32x2 a = *(const u32x2*)(base + off0), b = *(const u32x2*)(base + off1);
    u32x4 w; w.x = a.x; w.y = a.y; w.z = b.x; w.w = b.y; return __builtin_bit_cast(bf16x8, w);
}
#define LDS_BARRIER() do { asm volatile("s_waitcnt lgkmcnt(0)" ::: "memory"); __builtin_amdgcn_s_barrier(); asm volatile("" ::: "memory"); } while (0)
DI void gdn_scan_phase(const Ctx& c, const bf16_t* Qn, const bf16_t* KT, const bf16_t* UT, const bf16_t* Wn, const bf16_t* Aqk, const float* Gc, bf16_t* Og) {
    const bool loader = c.wid >= 4;
    for (int item = c.bid; item < NB * 16 * 2; item += c.G) {
        const int lane = lane_id(), lt = (c.wid - 4) * 64 + lane, m = lane & 15, g = lane >> 4;
        const int half = item & 1, h = (item >> 1) & 15, b = item >> 5;
        const int u0 = (b * 16 + h) * 32, col0 = half * 64 + 16 * c.wid;
        f32x4 S[8];
#pragma unroll
        for (int i = 0; i < 8; ++i) S[i] = (f32x4){0.f, 0.f, 0.f, 0.f};
        __syncthreads();
#define SC_P(x) ((((x) & ~7) | (((x) & 3) << 1) | (((x) >> 2) & 1)))
#define SC_LOAD(nn) do { const int u = u0 + (nn); const int tok0 = b * SEQ + 64 * (nn); \
            _Pragma("unroll") for (int k = 0; k < 4; ++k) { const int idx = lt + 256 * k, row = idx >> 4, cc = idx & 15; \
                st[k] = *(const u32x4*)(Wn + (size_t)u * 8192 + idx * 8);            \
                st[4 + k] = *(const u32x4*)(Qn + (size_t)u * 8192 + row * 128 + 8 * cc); } \
            _Pragma("unroll") for (int k = 0; k < 4; ++k) { const int idx = lt + 256 * k; st[8 + k] = *(const u32x4*)(KT + (size_t)u * 8192 + idx * 8); }   \
            _Pragma("unroll") for (int k = 0; k < 2; ++k) { const int idx = lt + 256 * k; st[12 + k] = *(const u32x4*)(Aqk + (size_t)u * 4096 + idx * 8); \
                st[14 + k] = *(const u32x4*)(UT + (size_t)u * 8192 + (size_t)(idx >> 5) * 512 + (size_t)half * 256 + (idx & 31) * 8); }     \
            if (lt < 64) { sg = Gc[(size_t)(tok0 + lt) * 16 + h]; sgl = Gc[(size_t)(tok0 + 63) * 16 + h]; } } while (0)
#define SC_WRITE(bufp) do { unsigned char* bb = (bufp); \
            _Pragma("unroll") for (int k = 0; k < 4; ++k) { const int idx = lt + 256 * k, row = idx >> 4, cc = idx & 15, gq = idx >> 5, pr = idx & 31; \
                *(u32x2*)(bb + SC_W + (2 * pr) * 272 + SC_P(gq) * 8) = (u32x2){st[k].x, st[k].y}; *(u32x2*)(bb + SC_W + (2 * pr + 1) * 272 + SC_P(gq) * 8) = (u32x2){st[k].z, st[k].w}; \
                *(u32x2*)(bb + SC_Q + row * 272 + SC_P(2 * cc) * 8) = (u32x2){st[4 + k].x, st[4 + k].y}; *(u32x2*)(bb + SC_Q + row * 272 + SC_P(2 * cc + 1) * 8) = (u32x2){st[4 + k].z, st[4 + k].w}; } \
            _Pragma("unroll") for (int k = 0; k < 4; ++k) { const int idx = lt + 256 * k, row = idx & 127, cc = idx >> 7; *(u32x2*)(bb + SC_K + row * 144 + SC_P(2 * cc) * 8) = (u32x2){st[8 + k].x, st[8 + k].y}; *(u32x2*)(bb + SC_K + row * 144 + SC_P(2 * cc + 1) * 8) = (u32x2){st[8 + k].z, st[8 + k].w}; } \
            _Pragma("unroll") for (int k = 0; k < 2; ++k) { const int idx = lt + 256 * k, gq = idx >> 5, pr = idx & 31; \
                *(u32x2*)(bb + SC_A + (2 * pr) * 144 + SC_P(gq) * 8) = (u32x2){st[12 + k].x, st[12 + k].y}; *(u32x2*)(bb + SC_A + (2 * pr + 1) * 144 + SC_P(gq) * 8) = (u32x2){st[12 + k].z, st[12 + k].w}; \
                *(u32x2*)(bb + SC_U + (2 * pr) * 144 + gq * 8) = (u32x2){st[14 + k].x, st[14 + k].y}; *(u32x2*)(bb + SC_U + (2 * pr + 1) * 144 + gq * 8) = (u32x2){st[14 + k].z, st[14 + k].w}; } \
            if (lt < 64) { float* ee = (float*)(bb + SC_E); ee[lt] = __expf(sg); ee[64 + lt] = __expf(sgl - sg); if (lt == 0) ee[128] = __expf(sgl); } } while (0)
        if (loader) {
            u32x4 stA[16], stB[16]; float sgA = 0.f, sglA = 0.f, sgB = 0.f, sglB = 0.f;
            { u32x4 st[16]; float sg = 0.f, sgl = 0.f; SC_LOAD(0); SC_WRITE(c.lds); }
            { u32x4 (&st)[16] = stA; float& sg = sgA; float& sgl = sglA; SC_LOAD(1); }
            LDS_BARRIER();
#pragma unroll 1
            for (int n = 0; n < 32; n += 2) {
                { u32x4 (&st)[16] = stB; float& sg = sgB; float& sgl = sglB; if (n + 2 < 32) SC_LOAD(n + 2); }
                { u32x4 (&st)[16] = stA; float& sg = sgA; float& sgl = sglA; SC_WRITE(c.lds + SC_BUF); }
                LDS_BARRIER();
                { u32x4 (&st)[16] = stA; float& sg = sgA; float& sgl = sglA; if (n + 3 < 32) SC_LOAD(n + 3); }
                { u32x4 (&st)[16] = stB; float& sg = sgB; float& sgl = sglB; if (n + 2 < 32) SC_WRITE(c.lds); }
                LDS_BARRIER();
            }
        } else {
            LDS_BARRIER();
#pragma unroll 1
            for (int n = 0; n < 32; ++n) {
                unsigned char* buf = c.lds + (n & 1) * SC_BUF;
                const int tok0 = b * SEQ + 64 * n;
                const float* ee = (const float*)(buf + SC_E);
                f32x4 Vn[4], O[4];
#pragma unroll
                for (int mt = 0; mt < 4; ++mt) { Vn[mt] = (f32x4){0.f, 0.f, 0.f, 0.f}; O[mt] = (f32x4){0.f, 0.f, 0.f, 0.f}; }
                bf16x8 BS[4];
#pragma unroll
                for (int s = 0; s < 4; ++s) BS[s] = pack8f(S[2 * s][0], S[2 * s][1], S[2 * s][2], S[2 * s][3], S[2 * s + 1][0], S[2 * s + 1][1], S[2 * s + 1][2], S[2 * s + 1][3]);
                bf16x8 fa[16];
#pragma unroll
                for (int mt = 0; mt < 4; ++mt)
#pragma unroll
                    for (int s = 0; s < 4; ++s) fa[mt * 4 + s] = *(const bf16x8*)(buf + SC_W + (16 * mt + m) * 272 + (8 * s + 2 * g) * 8);
                __builtin_amdgcn_sched_barrier(0);
#pragma unroll
                for (int mt = 0; mt < 4; ++mt)
#pragma unroll
                    for (int s = 0; s < 4; ++s) Vn[mt] = MFMA16(fa[mt * 4 + s], BS[s], Vn[mt]);
                __builtin_amdgcn_sched_barrier(0);
#pragma unroll
                for (int mt = 0; mt < 4; ++mt)
#pragma unroll
                    for (int s = 0; s < 4; ++s) fa[mt * 4 + s] = *(const bf16x8*)(buf + SC_Q + (16 * mt + m) * 272 + (8 * s + 2 * g) * 8);
                __builtin_amdgcn_sched_barrier(0);
#pragma unroll
                for (int mt = 0; mt < 4; ++mt)
#pragma unroll
                    for (int s = 0; s < 4; ++s) O[mt] = MFMA16(fa[mt * 4 + s], BS[s], O[mt]);
                __builtin_amdgcn_sched_barrier(0);
                bf16x8 fb2[8];
#pragma unroll
                for (int mt = 0; mt < 4; ++mt)
#pragma unroll
                    for (int s = 0; s < 2; ++s) fb2[mt * 2 + s] = *(const bf16x8*)(buf + SC_A + (16 * mt + m) * 144 + (8 * s + 2 * g) * 8);
#pragma unroll
                for (int dt = 0; dt < 4; ++dt)
#pragma unroll
                    for (int s = 0; s < 2; ++s) fa[dt * 2 + s] = *(const bf16x8*)(buf + SC_K + (16 * dt + m) * 144 + (8 * s + 2 * g) * 8);
                bf16x8 BV[2], BVd[2];
                {
                    f32x4 eg[4], ed[4];
#pragma unroll
                    for (int mt = 0; mt < 4; ++mt) { eg[mt] = *(const f32x4*)(ee + 16 * mt + 4 * g); ed[mt] = *(const f32x4*)(ee + 64 + 16 * mt + 4 * g); O[mt] *= eg[mt];
                        const u32x2 w = *(const u32x2*)(buf + SC_U + (16 * c.wid + m) * 144 + (16 * mt + 4 * g) * 2);
                        Vn[mt] += (f32x4){lo2f(w.x), hi2f(w.x), lo2f(w.y), hi2f(w.y)}; }
#pragma unroll
                    for (int s = 0; s < 2; ++s) {
                        const f32x4 a = Vn[2 * s], bq = Vn[2 * s + 1], ad = a * ed[2 * s], bd = bq * ed[2 * s + 1];
                        BV[s] = pack8f(a[0], a[1], a[2], a[3], bq[0], bq[1], bq[2], bq[3]);
                        BVd[s] = pack8f(ad[0], ad[1], ad[2], ad[3], bd[0], bd[1], bd[2], bd[3]);
                    }
                }
#pragma unroll
                for (int mt = 0; mt < 4; ++mt)
#pragma unroll
                    for (int s = 0; s < 2; ++s) O[mt] = MFMA16(fb2[mt * 2 + s], BV[s], O[mt]);
                const float glv = ee[128];
#pragma unroll
                for (int dt = 0; dt < 8; ++dt) S[dt] *= glv;
#pragma unroll
                for (int dt = 0; dt < 4; ++dt)
#pragma unroll
                    for (int s = 0; s < 2; ++s) S[dt] = MFMA16(fa[dt * 2 + s], BVd[s], S[dt]);
                __builtin_amdgcn_sched_barrier(0);
#pragma unroll
                for (int dt = 0; dt < 4; ++dt)
#pragma unroll
                    for (int s = 0; s < 2; ++s) fa[8 + dt * 2 + s] = *(const bf16x8*)(buf + SC_K + (16 * (4 + dt) + m) * 144 + (8 * s + 2 * g) * 8);
                __builtin_amdgcn_sched_barrier(0);
#pragma unroll
                for (int dt = 0; dt < 4; ++dt)
#pragma unroll
                    for (int s = 0; s < 2; ++s) S[4 + dt] = MFMA16(fa[8 + dt * 2 + s], BVd[s], S[4 + dt]);
#pragma unroll
                for (int mt = 0; mt < 4; ++mt)
#pragma unroll
                    for (int r = 0; r < 4; ++r) Og[(size_t)(tok0 + 16 * mt + 4 * g + r) * DM + h * 128 + col0 + m] = f2bf(O[mt][r]);
                LDS_BARRIER();
            }
        }
#undef SC_LOAD
#undef SC_WRITE
#undef SC_P
    }
}

DI void gdn_gnorm_phase(const Ctx& c, const bf16_t* O, const bf16_t* Pz, const float* onorm  , bf16_t* og) {
    const int gw = c.bid * NWAVES + c.wid, GW = c.G * NWAVES;
    const f32x4 wa = *(const f32x4*)(onorm + 8 * (c.lane & 15)), wb = *(const f32x4*)(onorm + 8 * (c.lane & 15) + 4);
    for (int tok = gw; tok < M_TOK; tok += 2 * GW) {
        u32x4 ow[2][4], zw[2][4];
#pragma unroll
        for (int r = 0; r < 2; ++r)
#pragma unroll
            for (int i = 0; i < 4; ++i) { const size_t off = (size_t)(tok + r * GW) * DM + 512 * i + 8 * c.lane; ow[r][i] = *(const u32x4*)(O + off); zw[r][i] = *(const u32x4*)(Pz + off); }
#pragma unroll
        for (int r = 0; r < 2; ++r)
#pragma unroll
            for (int i = 0; i < 4; ++i) {
                const u32x4 a = ow[r][i], z = zw[r][i];
                float o[8] = {lo2f(a.x), hi2f(a.x), lo2f(a.y), hi2f(a.y), lo2f(a.z), hi2f(a.z), lo2f(a.w), hi2f(a.w)};
                const float zz[8] = {lo2f(z.x), hi2f(z.x), lo2f(z.y), hi2f(z.y), lo2f(z.z), hi2f(z.z), lo2f(z.w), hi2f(z.w)};
                float ss = 0.f;
#pragma unroll
                for (int e = 0; e < 8; ++e) ss += o[e] * o[e];
                ss += dpp_mov<0xB1>(ss); ss += dpp_mov<0x4E>(ss); ss += dpp_mov<0x141>(ss); ss += dpp_mov<0x140>(ss);
                const float rs = rsqrtf(ss * (1.0f / 128.0f) + NORM_EPS);
#pragma unroll
                for (int e = 0; e < 4; ++e) { o[e] = o[e] * rs * wa[e] * silu_f(zz[e]); o[4 + e] = o[4 + e] * rs * wb[e] * silu_f(zz[4 + e]); }
                u32x4 w; w.x = pack2(o[0], o[1]); w.y = pack2(o[2], o[3]); w.z = pack2(o[4], o[5]); w.w = pack2(o[6], o[7]);
                *(u32x4*)(og + (size_t)(tok + r * GW) * DM + 512 * i + 8 * c.lane) = w;
            }
    }
}

DI void rope_k_phase(const Ctx& c, bf16_t* T, const float* ctab, const float* stab) {
    for (int i = c.bid * NTHREADS + c.tid; i < 32 * 2048 * 16; i += c.G * NTHREADS) {
        const int j = i & 15, row = i >> 4, bg = row >> 11, s = row & 2047, tok = (bg >> 2) * 2048 + s;
        const float cs = ctab[tok * 16 + j], sn = stab[tok * 16 + j];
        bf16_t* p = T + (size_t)row * 128;
        const float x1 = bf2f(p[j]), x2 = bf2f(p[16 + j]);
        p[j] = f2bf(x1 * cs - x2 * sn); p[16 + j] = f2bf(x2 * cs + x1 * sn);
    }
}
DI void rope_q_phase(const Ctx& c, const bf16_t* Q, bf16_t* QR, const float* ctab, const float* stab) {
    for (int i = c.bid * NTHREADS + c.tid; i < NB * 16 * 2048 * 16; i += c.G * NTHREADS) {
        const int ch = i & 15, row = i >> 4, b = row >> 15, s = row & 2047, tok = b * 2048 + s;
        const bf16_t* q = Q + (size_t)row * 128; bf16_t* o = QR + (size_t)row * 128;
        if (ch >= 4) { *(u32x4*)(o + 8 * ch) = *(const u32x4*)(q + 8 * ch); }
        else if (ch < 2) {
            const u32x4 a = *(const u32x4*)(q + 8 * ch), bq = *(const u32x4*)(q + 16 + 8 * ch);
            u32x4 ra, rb;
#pragma unroll
            for (int e = 0; e < 4; ++e) {
                const int j0 = 8 * ch + 2 * e;
                const float c0 = ctab[tok * 16 + j0], s0 = stab[tok * 16 + j0], c1 = ctab[tok * 16 + j0 + 1], s1 = stab[tok * 16 + j0 + 1];
                const float x10 = lo2f(a[e]), x11 = hi2f(a[e]), x20 = lo2f(bq[e]), x21 = hi2f(bq[e]);
                ra[e] = pack2(x10 * c0 - x20 * s0, x11 * c1 - x21 * s1);
                rb[e] = pack2(x20 * c0 + x10 * s0, x21 * c1 + x11 * s1);
            }
            *(u32x4*)(o + 8 * ch) = ra; *(u32x4*)(o + 16 + 8 * ch) = rb;
        }
    }
}
DI void cmp_w2_phase(const Ctx& c, const float* part, const float* biask, const float* biasv, const bf16_t* w2kt, bf16_t* kc, const bf16_t* w2vt, bf16_t* vc) {
    constexpr int HS = 520;
    bf16_t* Hl = (bf16_t*)c.lds;
    for (int item = c.bid; item < 128; item += c.G) {
        const int lane = lane_id(), tid = c.wid * 64 + lane, m = lane & 15, g = lane >> 4;
        const int pr = item >> 6, r0 = (item & 63) * 64;
        const float* bias = pr ? biasv : biask; const bf16_t* Wt = pr ? w2vt : w2kt; bf16_t* out = pr ? vc : kc;
        __syncthreads();
        {
            const int row = tid >> 3, cb = (tid & 7) * 64;
            const float* p0 = part + ((size_t)(pr * 4) * 4096 + r0 + row) * 512 + cb;
#pragma unroll
            for (int q = 0; q < 4; ++q) {
                f32x4 v[4];
#pragma unroll
                for (int e = 0; e < 4; ++e) v[e] = *(const f32x4*)(bias + cb + 16 * q + 4 * e);
#pragma unroll
                for (int ks = 0; ks < 4; ++ks)
#pragma unroll
                    for (int e = 0; e < 4; ++e) v[e] += *(const f32x4*)(p0 + (size_t)ks * 4096 * 512 + 16 * q + 4 * e);
                u32x4 w0, w1;
                w0.x = pack2(silu_f(v[0][0]), silu_f(v[0][1])); w0.y = pack2(silu_f(v[0][2]), silu_f(v[0][3])); w0.z = pack2(silu_f(v[1][0]), silu_f(v[1][1])); w0.w = pack2(silu_f(v[1][2]), silu_f(v[1][3]));
                w1.x = pack2(silu_f(v[2][0]), silu_f(v[2][1])); w1.y = pack2(silu_f(v[2][2]), silu_f(v[2][3])); w1.z = pack2(silu_f(v[3][0]), silu_f(v[3][1])); w1.w = pack2(silu_f(v[3][2]), silu_f(v[3][3]));
                *(u32x4*)(Hl + row * HS + cb + 16 * q) = w0; *(u32x4*)(Hl + row * HS + cb + 16 * q + 8) = w1;
            }
        }
        __syncthreads();
        const bf16_t* bp = Wt + (size_t)(16 * c.wid + m) * 512 + 8 * g;
        f32x4 acc[4];
#pragma unroll
        for (int mt = 0; mt < 4; ++mt) acc[mt] = (f32x4){0.f, 0.f, 0.f, 0.f};
#pragma unroll
        for (int bt = 0; bt < 4; ++bt) {
            bf16x8 bfr[4];
#pragma unroll
            for (int s = 0; s < 4; ++s) bfr[s] = *(const bf16x8*)(bp + 32 * (4 * bt + s));
#pragma unroll
            for (int s = 0; s < 4; ++s)
#pragma unroll
                for (int mt = 0; mt < 4; ++mt) acc[mt] = MFMA16(*(const bf16x8*)(Hl + (16 * mt + m) * HS + 32 * (4 * bt + s) + 8 * g), bfr[s], acc[mt]);
        }
#pragma unroll
        for (int mt = 0; mt < 4; ++mt)
#pragma unroll
            for (int r = 0; r < 4; ++r) out[(size_t)(r0 + 16 * mt + 4 * g + r) * 128 + 16 * c.wid + m] = f2bf(acc[mt][r]);
    }
}

DI void moe_route_phase(const Ctx& c, const float* rl, unsigned* gcnt, int* tok_e, int* tok_r, float* tok_w) {
    int* lcnt = (int*)c.lds; int* lbase = lcnt + 8;
    for (int chunk = c.bid; chunk < M_TOK / 64; chunk += c.G) {
        __syncthreads();
        if (c.tid < 8) lcnt[c.tid] = 0;
        __syncthreads();
        int e0 = 0, e1 = 1, r0 = 0, r1 = 0; float w0 = 0.f, w1 = 0.f;
        const int tok = chunk * 64 + c.tid;
        if (c.tid < 64) {
            const f32x4 a = *(const f32x4*)(rl + (size_t)tok * 8), b = *(const f32x4*)(rl + (size_t)tok * 8 + 4);
            const float lg[8] = {a[0], a[1], a[2], a[3], b[0], b[1], b[2], b[3]};
            float m0 = lg[0]; e0 = 0;
#pragma unroll
            for (int e = 1; e < 8; ++e) if (lg[e] > m0) { m0 = lg[e]; e0 = e; }
            float m1 = -3.0e38f; e1 = -1;
#pragma unroll
            for (int e = 0; e < 8; ++e) if (e != e0 && (e1 < 0 || lg[e] > m1)) { m1 = lg[e]; e1 = e; }
            w0 = 1.0f / (1.0f + __expf(m1 - m0)); w1 = 1.0f - w0;
            r0 = atomicAdd(&lcnt[e0], 1); r1 = atomicAdd(&lcnt[e1], 1);
        }
        __syncthreads();
        if (c.tid < 8) lbase[c.tid] = (int)__hip_atomic_fetch_add(gcnt + c.tid, (unsigned)lcnt[c.tid], __ATOMIC_RELAXED, __HIP_MEMORY_SCOPE_AGENT);
        __syncthreads();
        if (c.tid < 64) {
            tok_e[tok * 2] = e0; tok_e[tok * 2 + 1] = e1;
            tok_r[tok * 2] = lbase[e0] + r0; tok_r[tok * 2 + 1] = lbase[e1] + r1;
            tok_w[tok * 2] = w0; tok_w[tok * 2 + 1] = w1;
        }
    }
}
DI void moe_gather_phase(const Ctx& c, unsigned* gcnt, const int* tok_e, const int* tok_r, const float* tok_w, const bf16_t* hn, bf16_t* Aperm, int* slot_of, float* roww, int* tile_e) {
    int* segb = (int*)c.lds;
    __syncthreads();
    if (c.tid == 0) { int run = 0;
#pragma unroll 1
        for (int e = 0; e < 8; ++e) { const int cnt = (int)__hip_atomic_load(gcnt + e, __ATOMIC_RELAXED, __HIP_MEMORY_SCOPE_AGENT); segb[e] = run;
            const int nt = (cnt + 255) >> 8;
            if (c.bid == 0) {
#pragma unroll 1
                for (int t = 0; t < nt; ++t) tile_e[(run >> 8) + t] = e; }
            run += nt << 8; }
        if (c.bid == 0) tile_e[160] = run >> 8; }
    __syncthreads();
    const int gw = c.bid * NWAVES + c.wid, GW = c.G * NWAVES;
    for (int i = gw; i < 2 * M_TOK; i += GW) {
        const int tok = i >> 1, e = tok_e[i], slot = segb[e] + tok_r[i];
        const u32x4* src = (const u32x4*)(hn + (size_t)tok * DM); u32x4* dst = (u32x4*)(Aperm + (size_t)slot * DM);
#pragma unroll
        for (int j = 0; j < 4; ++j) dst[c.lane + 64 * j] = src[c.lane + 64 * j];
        if (c.lane == 0) { slot_of[i] = slot; roww[slot] = tok_w[i]; }
    }
}

namespace att {
constexpr int SHM_K = 16384, SHM_V = 16384;
constexpr int OFF_V = 0, OFF_K = 32768, OFF_WS = 65536, OFF_IMP = 73728, OFF_SEL = OFF_IMP + 8 * 32 * 33 * 4, OFF_UN = OFF_SEL + 256, OFF_SCL = OFF_UN + 16, OFF_OUT = OFF_IMP;
static_assert(OFF_SCL + 64 * 33 * 4 <= 8 * 18176 && OFF_OUT + 65536 <= 8 * 18176, "attention lds map");
constexpr float SCALE = 0.08838834764831845f, THR = 8.f;
#define KSWZ(row, colB) ((row) * 256 + ((colB) ^ (((row) & 7) << 4)))
DI int v_st(int k, int c) { const int kk = (k & ~0xC) | ((k & 4) << 1) | ((k & 8) >> 1); return ((kk >> 3) * 4 + (c >> 5)) * 512 + ((kk & 7) * 32 + (c & 31)) * 2; }
DI int v_rd_base(int lane) { return ((lane & 3) << 3) | (((lane >> 2) & 3) << 6) | (((lane >> 4) & 1) << 5) | (((lane >> 5) & 1) << 8); }
constexpr int v_rd_off(int d0, int ks, int half) { return d0 * 512 + ks * 4096 + half * 2048; }
typedef short s16x4 __attribute__((ext_vector_type(4)));
DI void mask_tile(f32x16& p0, f32x16& p1, int dq, unsigned W) {
    const float NEG = -__builtin_inff();
#pragma unroll
    for (int r = 0; r < 16; ++r) { const int cc = (r & 3) + 8 * (r >> 2);
        if ((unsigned)(dq - cc) >= W) p0[r] = NEG;
        if ((unsigned)(dq - cc - 32) >= W) p1[r] = NEG; }
}
DI void partialSM(f32x16& p0, f32x16& p1, float& m_reg, float& mn, float& alpha) {
    float pmax = p0[0];
#pragma unroll
    for (int r = 1; r < 16; ++r) pmax = fmaxf(pmax, p0[r]);
#pragma unroll
    for (int r = 0; r < 16; ++r) pmax = fmaxf(pmax, p1[r]);
    { auto rr = __builtin_amdgcn_permlane32_swap(__float_as_uint(pmax), __float_as_uint(pmax), false, false); pmax = fmaxf(__uint_as_float(rr[0]), __uint_as_float(rr[1])); }
    constexpr float C2 = 1.4426950408889634f * SCALE;
    if (__builtin_expect(__all((pmax - m_reg) * SCALE <= THR), 1)) { mn = m_reg; alpha = 1.f; }
    else { mn = fmaxf(m_reg, pmax); alpha = __builtin_amdgcn_exp2f((m_reg - mn) * C2); m_reg = mn; }
    const float mnL = -mn * C2;
#pragma unroll
    for (int r = 0; r < 16; ++r) { p0[r] = __builtin_amdgcn_exp2f(fmaf(p0[r], C2, mnL)); p1[r] = __builtin_amdgcn_exp2f(fmaf(p1[r], C2, mnL)); }
}
DI void p_frags(const f32x16& p0, const f32x16& p1, bf16x8& pa0, bf16x8& pa1, bf16x8& pa2, bf16x8& pa3) {
#define PK4(P, B_, OUT) do { const unsigned a0 = pack2(P[B_ + 0], P[B_ + 1]), a1 = pack2(P[B_ + 2], P[B_ + 3]), b0 = pack2(P[B_ + 4], P[B_ + 5]), b1 = pack2(P[B_ + 6], P[B_ + 7]); \
        auto r0 = __builtin_amdgcn_permlane32_swap(a0, b0, false, false); auto r1 = __builtin_amdgcn_permlane32_swap(a1, b1, false, false); \
        u32x4 w = {r0[0], r1[0], r0[1], r1[1]}; OUT = __builtin_bit_cast(bf16x8, w); } while (0)
    PK4(p0, 0, pa0); PK4(p0, 8, pa1); PK4(p1, 0, pa2); PK4(p1, 8, pa3);
#undef PK4
}
DI float row_sum(const f32x16& p0, const f32x16& p1) {
    float ps = 0.f;
#pragma unroll
    for (int r = 0; r < 16; ++r) ps += p0[r] + p1[r];
    auto rr = __builtin_amdgcn_permlane32_swap(__float_as_uint(ps), __float_as_uint(ps), false, false);
    return __uint_as_float(rr[0]) + __uint_as_float(rr[1]);
}
DI void qkt(f32x16& p0, f32x16& p1, const unsigned char* kbuf, int r32, int hi, const bf16x8* qr) {
    p0 = f32x16{}; p1 = f32x16{};
    const unsigned char* kb[4];
#pragma unroll
    for (int dd = 0; dd < 4; ++dd) kb[dd] = kbuf + KSWZ(r32, (dd * 16 + hi * 8) * 2);
#pragma unroll
    for (int d0 = 0; d0 < 8; ++d0) { const unsigned char* a = kb[d0 & 3] + (d0 >> 2) * 128;
        const bf16x8 b0 = *(const bf16x8*)a, b1 = *(const bf16x8*)(a + 32 * 256);
        p0 = MFMA32(b0, qr[d0], p0); p1 = MFMA32(b1, qr[d0], p1); }
}
DI void pv_tile(f32x16* o, int vb0, bf16x8 pa0, bf16x8 pa1, bf16x8 pa2, bf16x8 pa3) {
#define TRRD(dst, off) asm volatile("ds_read_b64_tr_b16 %0, %1 offset:%2" : "=&v"(dst) : "v"(vb0), "i"(off) : "memory")
#define PV_D0(d0) do { s16x4 l0, l1, l2, l3, h0, h1, h2, h3; constexpr int b_ = v_rd_off(d0, 0, 0); \
        TRRD(l0, b_); TRRD(h0, b_ + 2048); TRRD(l1, b_ + 4096); TRRD(h1, b_ + 6144); TRRD(l2, b_ + 8192); TRRD(h2, b_ + 10240); TRRD(l3, b_ + 12288); TRRD(h3, b_ + 14336); \
        asm volatile("s_waitcnt lgkmcnt(0)" ::: "memory"); __builtin_amdgcn_sched_barrier(0); \
        o[d0] = MFMA32(pa0, ((bf16x8){l0[0], l0[1], l0[2], l0[3], h0[0], h0[1], h0[2], h0[3]}), o[d0]); \
        o[d0] = MFMA32(pa1, ((bf16x8){l1[0], l1[1], l1[2], l1[3], h1[0], h1[1], h1[2], h1[3]}), o[d0]); \
        o[d0] = MFMA32(pa2, ((bf16x8){l2[0], l2[1], l2[2], l2[3], h2[0], h2[1], h2[2], h2[3]}), o[d0]); \
        o[d0] = MFMA32(pa3, ((bf16x8){l3[0], l3[1], l3[2], l3[3], h3[0], h3[1], h3[2], h3[3]}), o[d0]); } while (0)
    PV_D0(0); PV_D0(1); PV_D0(2); PV_D0(3);
#undef PV_D0
#undef TRRD
}
struct TileOff { unsigned k[2], v[2]; };
DI TileOff tile_offsets(int wid, int lane) {
    TileOff t;
#pragma unroll
    for (int i = 0; i < 2; ++i) {
        const int P = i * 8192 + wid * 1024 + lane * 16;
        const int row = P >> 8, cpos = (P & 255) >> 4; t.k[i] = (unsigned)(row * 256 + ((cpos ^ (row & 7)) << 4));
        const int sub = P >> 9, off = P & 511, kk = (sub >> 2) * 8 + (off >> 6), col = (sub & 3) * 32 + ((off & 63) >> 1);
        const int key = (kk & ~0xC) | ((kk & 4) << 1) | ((kk & 8) >> 1);
        t.v[i] = (unsigned)(key * 256 + col * 2);
    }
    return t;
}
DI void tile_dma(unsigned char* lds, int buf, const bf16_t* Kt, const bf16_t* Vt, int wid, const TileOff& t) {
    LAS unsigned char* l = (LAS unsigned char*)lds;
#pragma unroll
    for (int i = 0; i < 2; ++i) {
        __builtin_amdgcn_global_load_lds((const unsigned*)((const char*)Kt + t.k[i]), (LAS unsigned*)(l + OFF_K + buf * SHM_K + i * 8192 + wid * 1024), 16, 0, 0);
        __builtin_amdgcn_global_load_lds((const unsigned*)((const char*)Vt + t.v[i]), (LAS unsigned*)(l + OFF_V + buf * SHM_V + i * 8192 + wid * 1024), 16, 0, 0);
    }
}
#define ATT_PUBLISH() do { asm volatile("s_waitcnt vmcnt(0)" ::: "memory"); __syncthreads(); } while (0)
DI void rescale(f32x16* o, float alpha, float* al_l, int r32, int hi) {
    if (__any(alpha < 1.f)) { if (hi == 0) al_l[r32] = alpha; asm volatile("s_waitcnt lgkmcnt(0)" ::: "memory");
#pragma unroll
        for (int r = 0; r < 16; ++r) { const float a = al_l[crow32(r, hi)];
#pragma unroll
            for (int d = 0; d < 4; ++d) o[d][r] *= a; } }
}
template <int MODE>
DI void flash_branch(unsigned char* lds, const bf16_t* Kb, const bf16_t* Vb, const bf16x8* qr, unsigned tmask, unsigned selbits, int n, int qpos,
                     f32x16* o, float& l_reg, float* al_l, int r32, int hi, int wid, const TileOff& toff, int lane) {
    float m_reg = -1e30f; l_reg = 0.f;
#pragma unroll
    for (int d = 0; d < 4; ++d) o[d] = f32x16{};
    unsigned rest = tmask;
    int jc = __builtin_ctz(rest); rest &= rest - 1;
    tile_dma(lds, 0, Kb + (size_t)jc * 64 * 128, Vb + (size_t)jc * 64 * 128, wid, toff);
    ATT_PUBLISH();
    int bc = 0;
    for (;;) {
        const bool have_n = rest != 0u; const int jn = have_n ? __builtin_ctz(rest) : 0; if (have_n) rest &= rest - 1;
        if (have_n) tile_dma(lds, bc ^ 1, Kb + (size_t)jn * 64 * 128, Vb + (size_t)jn * 64 * 128, wid, toff);
        f32x16 p0, p1;
        qkt(p0, p1, lds + OFF_K + bc * SHM_K, r32, hi, qr);
        if (MODE == 0) {
            if (!((selbits >> jc) & 1u)) { const float NEG = -__builtin_inff();
#pragma unroll
                for (int r = 0; r < 16; ++r) { p0[r] = NEG; p1[r] = NEG; } }
            else if (jc == n) mask_tile(p0, p1, qpos - 64 * jc - 4 * hi, 0x40000000u);
        } else {
            if (jc == n || jc + 8 <= n) mask_tile(p0, p1, qpos - 64 * jc - 4 * hi, 512u);
        }
        float mn, alpha;
        partialSM(p0, p1, m_reg, mn, alpha);
        l_reg = l_reg * alpha + row_sum(p0, p1);
        bf16x8 pa0, pa1, pa2, pa3;
        p_frags(p0, p1, pa0, pa1, pa2, pa3);
        rescale(o, alpha, al_l, r32, hi);
        pv_tile(o, (int)(uintptr_t)(lds + OFF_V + bc * SHM_V) + v_rd_base(lane), pa0, pa1, pa2, pa3);
        if (!have_n) break;
        ATT_PUBLISH();
        bc ^= 1; jc = jn;
    }
    ATT_PUBLISH();
}
}

DI void nsa_attn_phase(const Ctx& c, const bf16_t* Q, const bf16_t* QR, const bf16_t* skv, const bf16_t* kcmp, const bf16_t* vcmp, const float* gates, bf16_t* PC, bf16_t* PS, bf16_t* AO) {
    using namespace att;
    unsigned char* lds = c.lds;
    const int hh = c.wid >> 1, th = c.wid & 1;
    const size_t TSZ = (size_t)32 * 2048 * 128;
    float* wsf = (float*)(lds + OFF_WS + c.wid * 1024); float* li_l = wsf; float* al_l = wsf + 32; float* gl = wsf + 64;
    float* impw = (float*)(lds + OFF_IMP); unsigned* selm = (unsigned*)(lds + OFF_SEL); unsigned* unw = (unsigned*)(lds + OFF_UN); float* scl = (float*)(lds + OFF_SCL);
    for (int i = 0;; ++i) {
        const int L = i * c.G + c.bid; if (L >= 1024) break;
        int lane_ = lane_id();
        const int lane = lane_, r32 = lane & 31, hi = lane >> 5, tid = c.wid * 64 + lane;
        const int k = L >> 8, rr = L & 255, jj = rr >> 5, bg = rr & 31;
        const int n = (k == 0) ? 31 - jj : (k == 1) ? 16 + jj : (k == 2) ? 15 - jj : jj;
        const int b = bg >> 2, g = bg & 3, head = 4 * g + hh, t0 = 64 * n, qpos = t0 + 32 * th + r32, tok = b * SEQ + qpos;
        const size_t qoff = ((size_t)(b * 16 + head) * 2048 + qpos) * 128 + 8 * hi;
        const size_t obase = (size_t)(b * SEQ + t0 + 32 * th) * DM + head * 128 + r32;
        bf16x8 qr[8];
#pragma unroll
        for (int d0 = 0; d0 < 8; ++d0) qr[d0] = *(const bf16x8*)(Q + qoff + 16 * d0);
        if (hi == 0) { const float* gt = gates + (size_t)tok * 48 + head * 3; gl[r32] = fast_sigmoid(gt[0]); gl[32 + r32] = fast_sigmoid(gt[1]); gl[64 + r32] = fast_sigmoid(gt[2]); }
        if (tid == 0) unw[0] = 0u;
        if (tid < 64) selm[tid] = 0u;
        const TileOff toff = tile_offsets(c.wid, lane);
        tile_dma(lds, 0, kcmp + (size_t)bg * 128 * 128, vcmp + (size_t)bg * 128 * 128, c.wid, toff);
        tile_dma(lds, 1, kcmp + (size_t)bg * 128 * 128 + 64 * 128, vcmp + (size_t)bg * 128 * 128 + 64 * 128, c.wid, toff);
        ATT_PUBLISH();
        unsigned* Ool = (unsigned*)(lds + OFF_OUT + c.wid * 8192) + lane;
        unsigned oc_keep[4][8];
        {
            f32x16 pA0, pA1, pB0, pB1;
            qkt(pA0, pA1, lds + OFF_K, r32, hi, qr);
            qkt(pB0, pB1, lds + OFF_K + SHM_K, r32, hi, qr);
            const int cmax = (qpos >= 31) ? ((qpos - 31) >> 4) : -1, lim = cmax - 4 * hi;
            const float NEG = -__builtin_inff();
#pragma unroll
            for (int r = 0; r < 16; ++r) { const int cc = (r & 3) + 8 * (r >> 2);
                if (cc > lim) pA0[r] = NEG; if (cc + 32 > lim) pA1[r] = NEG; if (cc + 64 > lim) pB0[r] = NEG; if (cc + 96 > lim) pB1[r] = NEG; }
            float pmax = -1e30f;
#pragma unroll
            for (int r = 0; r < 16; ++r) pmax = fmaxf(fmaxf(pmax, pA0[r]), fmaxf(pA1[r], fmaxf(pB0[r], pB1[r])));
            { auto x = __builtin_amdgcn_permlane32_swap(__float_as_uint(pmax), __float_as_uint(pmax), false, false); pmax = fmaxf(__uint_as_float(x[0]), __uint_as_float(x[1])); }
            constexpr float C2 = 1.4426950408889634f * SCALE;
            const float mnL = -pmax * C2;
#pragma unroll
            for (int r = 0; r < 16; ++r) { pA0[r] = __builtin_amdgcn_exp2f(fmaf(pA0[r], C2, mnL)); pA1[r] = __builtin_amdgcn_exp2f(fmaf(pA1[r], C2, mnL));
                pB0[r] = __builtin_amdgcn_exp2f(fmaf(pB0[r], C2, mnL)); pB1[r] = __builtin_amdgcn_exp2f(fmaf(pB1[r], C2, mnL)); }
            const float l = row_sum(pA0, pA1) + row_sum(pB0, pB1);
            const float inv = (l > 0.f) ? 1.0f / l : 0.f;
#pragma unroll
            for (int r = 0; r < 16; ++r) { pA0[r] *= inv; pA1[r] *= inv; pB0[r] *= inv; pB1[r] *= inv; }
            float* myimp = impw + (size_t)(c.wid * 32 + r32) * 33;
#define IMP_MAIN(P, base) do { _Pragma("unroll") for (int q = 0; q < 4; ++q) myimp[(base) + 2 * q + hi] = 2.0f * (P[4 * q] + P[4 * q + 1] + P[4 * q + 2]) + P[4 * q + 3]; } while (0)
            IMP_MAIN(pA0, 0); IMP_MAIN(pA1, 8); IMP_MAIN(pB0, 16); IMP_MAIN(pB1, 24);
#undef IMP_MAIN
            asm volatile("s_waitcnt lgkmcnt(0)" ::: "memory");
#define IMP_CARRY(P, base) do { _Pragma("unroll") for (int q = 0; q < 4; ++q) { const int jn1 = (base) + 2 * q + hi + 1; if (jn1 < 32) myimp[jn1] += P[4 * q + 3]; } } while (0)
            IMP_CARRY(pA0, 0); IMP_CARRY(pA1, 8); IMP_CARRY(pB0, 16); IMP_CARRY(pB1, 24);
#undef IMP_CARRY
            bf16x8 pa0, pa1, pa2, pa3;
            f32x16 o[4];
#pragma unroll
            for (int d = 0; d < 4; ++d) o[d] = f32x16{};
            p_frags(pA0, pA1, pa0, pa1, pa2, pa3);
            pv_tile(o, (int)(uintptr_t)(lds + OFF_V) + v_rd_base(lane), pa0, pa1, pa2, pa3);
            p_frags(pB0, pB1, pa0, pa1, pa2, pa3);
            pv_tile(o, (int)(uintptr_t)(lds + OFF_V + SHM_V) + v_rd_base(lane), pa0, pa1, pa2, pa3);
            asm volatile("s_waitcnt lgkmcnt(0)" ::: "memory");
#pragma unroll
            for (int r = 0; r < 16; r += 2) { const float g0 = gl[crow32(r, hi)], g1 = gl[crow32(r + 1, hi)];
#pragma unroll
                for (int d = 0; d < 4; ++d) oc_keep[d][r >> 1] = pack2(o[d][r] * g0, o[d][r + 1] * g1); }
        }
        __syncthreads();
        {
            const int tt = tid & 63, jg = tid >> 6, tth = tt >> 5, tr = tt & 31, tpos = t0 + tt, cur = n;
            float mys[4];
#pragma unroll
            for (int e = 0; e < 4; ++e) { const int j = 4 * jg + e; float v = 0.f;
#pragma unroll
                for (int h4 = 0; h4 < 4; ++h4) v += impw[(size_t)((2 * h4 + tth) * 32 + tr) * 33 + j];
                const bool forced = (j == 0) || (j == cur) || (j == cur - 1), causal = (j * 64 <= tpos);
                mys[e] = forced ? 1e9f : (causal ? v : -1e9f); scl[tt * 33 + j] = mys[e]; }
            __syncthreads();
            int rank[4] = {0, 0, 0, 0};
#pragma unroll 4
            for (int j2 = 0; j2 < 32; ++j2) { const float s2 = scl[tt * 33 + j2];
#pragma unroll
                for (int e = 0; e < 4; ++e) rank[e] += (s2 > mys[e] || (s2 == mys[e] && j2 < 4 * jg + e)) ? 1 : 0; }
            unsigned bits = 0u;
#pragma unroll
            for (int e = 0; e < 4; ++e) bits |= (rank[e] < 16) ? (1u << (4 * jg + e)) : 0u;
            bits &= (cur >= 31) ? 0xffffffffu : ((2u << cur) - 1u);
            if (bits) { atomicOr(selm + tt, bits); atomicOr(unw, bits); }
        }
        __syncthreads();
        const unsigned selbits = selm[32 * th + r32], un = unw[0];
        __syncthreads();
#pragma unroll
        for (int d = 0; d < 4; ++d)
#pragma unroll
            for (int q = 0; q < 8; ++q) Ool[(d * 8 + q) * 64] = oc_keep[d][q];
#pragma unroll
        for (int d0 = 0; d0 < 8; ++d0) qr[d0] = *(const bf16x8*)(QR + qoff + 16 * d0);
        const bf16_t* kbase = skv + (size_t)bg * 2048 * 128;
        {
            f32x16 o[4]; float l_reg;
            flash_branch<0>(lds, kbase + 2 * TSZ, kbase + 3 * TSZ, qr, un, selbits, n, qpos, o, l_reg, al_l, r32, hi, c.wid, toff, lane);
            if (hi == 0) li_l[r32] = l_reg;
            asm volatile("s_waitcnt lgkmcnt(0)" ::: "memory");
#pragma unroll
            for (int r = 0; r < 16; r += 2) { const int c0 = crow32(r, hi), c1 = crow32(r + 1, hi);
                const float g0 = gl[32 + c0] * __builtin_amdgcn_rcpf(li_l[c0]), g1 = gl[32 + c1] * __builtin_amdgcn_rcpf(li_l[c1]);
#pragma unroll
                for (int d = 0; d < 4; ++d) { const unsigned pv_ = Ool[(d * 8 + (r >> 1)) * 64]; Ool[(d * 8 + (r >> 1)) * 64] = pack2(lo2f(pv_) + o[d][r] * g0, hi2f(pv_) + o[d][r + 1] * g1); } }
        }
        {
            f32x16 o[4]; float l_reg;
            const int jlo = (n >= 8) ? n - 8 : 0;
            const unsigned wmask = ((n >= 31) ? 0xffffffffu : ((2u << n) - 1u)) & ~((1u << jlo) - 1u);
            flash_branch<1>(lds, kbase + 4 * TSZ, kbase + 5 * TSZ, qr, wmask, 0u, n, qpos, o, l_reg, al_l, r32, hi, c.wid, toff, lane);
            if (hi == 0) li_l[r32] = l_reg;
            asm volatile("s_waitcnt lgkmcnt(0)" ::: "memory");
            bf16_t* otl = (bf16_t*)(lds + OFF_V + c.wid * 8192);
#pragma unroll
            for (int r = 0; r < 16; ++r) { const int c0 = crow32(r, hi); const float g0 = gl[64 + c0] * __builtin_amdgcn_rcpf(li_l[c0]);
#pragma unroll
                for (int d = 0; d < 4; ++d) { const unsigned pv_ = Ool[(d * 8 + (r >> 1)) * 64]; const float prev = (r & 1) ? hi2f(pv_) : lo2f(pv_);
                    otl[c0 * 128 + 32 * d + r32] = f2bf(prev + o[d][r] * g0); } }
            asm volatile("s_waitcnt lgkmcnt(0)" ::: "memory"); __builtin_amdgcn_wave_barrier();
            bf16_t* orow = AO + (size_t)(b * SEQ + t0 + 32 * th) * DM + head * 128;
#pragma unroll
            for (int j = 0; j < 8; ++j) { const int ci = lane + 64 * j, row = ci >> 4, cc = ci & 15;
                *(u32x4*)(orow + (size_t)row * DM + 8 * cc) = *(const u32x4*)(otl + 8 * ci); }
        }
        __syncthreads();
    }
}

constexpr int ST_OFF = 8 * SOLVE_WAVE_LDS;
constexpr int LDS_BYTES = ST_OFF + 1024;
static_assert(ST_OFF >= pg8::STAGE_BYTES && 2 * SC_BUF <= ST_OFF, "lds map");
constexpr int NPH_MAX = 48;
constexpr int BAR_REGION_WORD0 = 16384, BAR_REGION_STRIDE = 4096;
typedef const Params __attribute__((address_space(4)))* KArgs;

DI void cvt_layer(const Ctx& c, KArgs p, int l, int& tb) {
    bf16_t* WB = (bf16_t*)(p->ws + WS_WB);
    if (l < 2) {
        const float* win = p->in[I_GDN_W_IN] + (size_t)l * 2048 * 8224;
        cvt_task(c, tb, win, 8224, 2048, 8192, 8192, WB + WB_MIX_IN / 2, 0);
        cvt_task(c, tb, win + 8192, 8224, 2048, 32, 64, WB + WB_SMALL / 2, 0);
        cvt_task(c, tb, p->in[I_GDN_W_OUT] + (size_t)l * 2048 * 2048, 2048, 2048, 2048, 2048, WB + WB_MIX_OUT / 2, 0);
    } else {
        const int j = l - 2; const float* wq = p->in[I_NSA_W_Q] + (size_t)j * 2048 * 2096;
        cvt_task(c, tb, wq, 2096, 2048, 2048, 2048, WB + WB_MIX_IN / 2, 0);
        cvt_task(c, tb, wq + 2048, 2096, 2048, 48, 64, WB + WB_SMALL / 2, 0);
        cvt_task(c, tb, p->in[I_NSA_W_O] + (size_t)j * 2048 * 2048, 2048, 2048, 2048, 2048, WB + WB_MIX_OUT / 2, 0);
    }
    const int j = l >> 1;
    if ((l & 1) == 0) {
        cvt_task(c, tb, p->in[I_FFN_W_GATE] + (size_t)j * 2048 * FFN, FFN, 2048, FFN, FFN, WB + WB_FFN / 2, 1);
        cvt_task(c, tb, p->in[I_FFN_W_UP] + (size_t)j * 2048 * FFN, FFN, 2048, FFN, FFN, WB + WB_FFN / 2, 2);
        cvt_task(c, tb, p->in[I_FFN_W_DOWN] + (size_t)j * FFN * 2048, 2048, FFN, 2048, 2048, WB + WB_FFN_DOWN_DENSE / 2, 0);
    } else {
#pragma unroll 1
        for (int e = 0; e < NEXP; ++e) {
            const size_t wo = (size_t)(j * NEXP + e) * 2048 * 2048;
            cvt_task(c, tb, p->in[I_MOE_W_GATE] + wo, 2048, 2048, 2048, 2048, WB + WB_FFN / 2 + (size_t)e * 4096 * 2048, 1);
            cvt_task(c, tb, p->in[I_MOE_W_UP] + wo, 2048, 2048, 2048, 2048, WB + WB_FFN / 2 + (size_t)e * 4096 * 2048, 2);
            cvt_task(c, tb, p->in[I_MOE_W_DOWN] + wo, 2048, 2048, 2048, 2048, WB + WB_MOE_DOWN / 2 + (size_t)e * 2048 * 2048, 0);
        }
        cvt_task(c, tb, p->in[I_MOE_ROUTER] + (size_t)j * 2048 * 8, 8, 2048, 8, 64, WB + WB_ROUTER / 2, 0);
    }
}

#ifndef R_OUT
#define R_OUT 1
#endif
#ifndef R_DOWN
#define R_DOWN 1
#endif
#ifndef R_GATHER
#define R_GATHER 1
#endif
#ifndef R_CMP
#define R_CMP 1
#endif
#ifndef R_P0
#define R_P0 1
#endif
#ifndef R_FINAL
#define R_FINAL 1
#endif
#ifndef R_PRE
#define R_PRE 1
#endif
#ifndef R_CVT
#define R_CVT 1
#endif
#ifndef R_INPROJ
#define R_INPROJ 1
#endif
#ifndef R_GDN
#define R_GDN 1
#endif
#ifndef R_CONV
#define R_CONV 1
#endif
#ifndef R_SOLVE
#define R_SOLVE 1
#endif
#ifndef R_SCAN
#define R_SCAN 1
#endif
#ifndef R_QKV
#define R_QKV 1
#endif
#ifndef R_ATT
#define R_ATT 1
#endif
#ifndef R_FFNGU
#define R_FFNGU 1
#endif
#ifndef R_MOEG
#define R_MOEG 1
#endif
#ifndef R_NORM
#define R_NORM 1
#endif
__global__ void __launch_bounds__(NTHREADS, 2) mega_fwd(Params p_unused) {
    extern __shared__ __attribute__((aligned(16))) unsigned char shm[];
    LAS unsigned char* ldsl = (LAS unsigned char*)shm;
    volatile LAS unsigned* st = (volatile LAS unsigned*)(ldsl + ST_OFF);
    const int wid_s = __builtin_amdgcn_readfirstlane((int)threadIdx.x >> 6);
    if (wid_s == 0 && lane_id() == 0) { st[0] = 0u; st[1] = 0u; st[2] = 0u; st[3] = 0u; }
    __syncthreads();
    KArgs kargs = (KArgs)__builtin_amdgcn_kernarg_segment_ptr();
    const int lo = kargs->ph_lo, hi = kargs->ph_hi;
    XcdBarrier bar; bar.bar = (unsigned*)(kargs->ws + WS_CTL) + BAR_REGION_WORD0 + (lo & 63) * BAR_REGION_STRIDE; bar.x = 0; bar.st = st;
    if (hi - lo > 1) bar = xcd_barrier_post(bar.bar, st, wid_s * 64 + lane_id());

    int pc = 0;
#define PH_BEGIN PH_BEGIN_R(1)
#define PH_BEGIN_R(R) if (pc >= lo && pc < hi) { _Pragma("unroll 1") for (int rep_ = 0; rep_ < (R); ++rep_) { KArgs p = kargs; asm volatile("" : "+s"(p)); int tid_ = wid_s * 64 + lane_id(); asm volatile("" : "+v"(tid_)); \
        Ctx c; c.lds = shm; c.tid = tid_; c.lane = tid_ & 63; c.wid = wid_s; c.G = gridDim.x; c.bid = blockIdx.x; \
        unsigned char* ws = p->ws; (void)ws; (void)c;
#define PH_END   } if (pc + 1 < hi) xcd_barrier(bar, wid_s * 64 + lane_id()); } ++pc;
#define CTX_REFRESH do { int t2_ = wid_s * 64 + lane_id(); asm volatile("" : "+v"(t2_)); c.tid = t2_; c.lane = t2_ & 63; } while (0)
#define SLOTP(i) ((bf16_t*)(ws + WS_SL + (size_t)(i) * SLOT))
#define WBP(off) ((bf16_t*)(ws + WS_WB + (off)))
#define WKVP(off) ((bf16_t*)(ws + WS_WKV + (off)))
#define AUXP(T, off) ((T*)(ws + WS_AUX + (off)))
#define HP ((bf16_t*)(ws + WS_H))
#define SKVP ((bf16_t*)(ws + WS_SKV))
#define CTAB ((float*)(ws + WS_WKV + WKV_ROPE))
#define STAB (CTAB + (size_t)M_TOK * 16)
#define TILE_E ((int*)((unsigned*)(ws + WS_CTL) + CW_TILEE))
    constexpr size_t TSZ = (size_t)32 * 2048 * 128;

    PH_BEGIN_R(R_P0)
        int tb = 0;
        for (int rc_ = 1; rc_ < R_CVT; ++rc_) { int tb2 = 0; cvt_layer(c, p, 0, tb2); }
        cvt_task(c, tb, p->in[I_NSA_W_KV], 3072, 2048, 3072, 3072, WKVP(WKV_KV), 0);
        cvt_task(c, tb, p->in[I_CMP_W1_K], 512, 4096, 512, 512, WKVP(WKV_W1K), 0);
        cvt_task(c, tb, p->in[I_CMP_W1_V], 512, 4096, 512, 512, WKVP(WKV_W1V), 0);
        cvt_task(c, tb, p->in[I_CMP_W2_K], 128, 512, 128, 128, WKVP(WKV_W2K), 0);
        cvt_task(c, tb, p->in[I_CMP_W2_V], 128, 512, 128, 128, WKVP(WKV_W2V), 0);
        cvt_layer(c, p, 0, tb);
        rope_table_phase(c, (const int*)p->in[I_POS], CTAB, STAB);
        cmp_bias_phase(c, p->in[I_CMP_POS_K], p->in[I_CMP_W1_K], p->in[I_CMP_POS_V], p->in[I_CMP_W1_V], (float*)(ws + WS_WKV + WKV_BPART));
        CTX_REFRESH;
        norm_phase<true, 2>(c, p->in[I_X], nullptr, nullptr, nullptr, p->in[I_ATTN_NORM], SLOTP(0), nullptr, nullptr, nullptr);
    PH_END

#pragma unroll 1
    for (int l = 0; l < 4; ++l) {
        if (l > 0) {
            PH_BEGIN
                int tb = 0; cvt_layer(c, p, l, tb);
                if (l == 1) cmp_bias_reduce(c, (const float*)(ws + WS_WKV + WKV_BPART), (float*)(ws + WS_WKV + WKV_BIASK), (float*)(ws + WS_WKV + WKV_BIASV));
                for (int rc_ = 1; rc_ < R_CVT; ++rc_) { int tb2 = 0; cvt_layer(c, p, l, tb2); }
                CTX_REFRESH;
                if (l == 2) norm_phase<false, 2>(c, HP, SLOTP(7), AUXP(int, AUX_SLOTOF), HP, p->in[I_KV_NORM], SLOTP(1), p->in[I_ATTN_NORM] + 2 * DM, SLOTP(0), nullptr);
                else norm_phase<false, 4>(c, HP, nullptr, nullptr, nullptr, p->in[I_ATTN_NORM] + (size_t)l * DM, SLOTP(0), nullptr, nullptr, nullptr);
            PH_END
        }
        if (l < 2) {
            PH_BEGIN_R(R_INPROJ)
                { pg8::Gemm g{2048, 2048, 2048}; pg8::SchedDense S; S.init(M_TOK, 8192, c.G, c.bid, SLOTP(0), 2048, WBP(WB_MIX_IN), 2048);
                  pg8::EpiSplit E{SLOTP(1), 2048, 2048, (size_t)SLOT / 2};
                  pg8::gemm_phase(ldsl, g, S, E, wid_s * 64 + lane_id()); }
                CTX_REFRESH; skinny_phase<2>(c, SLOTP(0), WBP(WB_SMALL), AUXP(float, AUX_SK), 32, 32);
            PH_END
            PH_BEGIN_R(R_CONV)
                gdn_conv2_phase(c, SLOTP(1), SLOTP(2), SLOTP(3), p->in[I_GDN_CONV] + (size_t)l * 4 * 6144, AUXP(float, AUX_SK), p->in[I_GDN_A_LOG] + l * 16, p->in[I_GDN_DT_BIAS] + l * 16,
                                SLOTP(6), SLOTP(5), SLOTP(10), SLOTP(7), AUXP(float, AUX_G), AUXP(float, AUX_BETA));
                asm volatile("s_waitcnt vmcnt(0)" ::: "memory");
                CTX_REFRESH;
                gdn_solve_phase(c, SLOTP(6), SLOTP(5), SLOTP(10), SLOTP(7), AUXP(float, AUX_G), AUXP(float, AUX_BETA), SLOTP(0), SLOTP(11), SLOTP(9));
            PH_END
            PH_BEGIN_R(R_SCAN)
                gdn_scan_phase(c, SLOTP(6), SLOTP(10), SLOTP(0), SLOTP(11), SLOTP(9), AUXP(float, AUX_G), SLOTP(8));
            PH_END
            PH_BEGIN_R(R_GDN)
                gdn_gnorm_phase(c, SLOTP(8), SLOTP(4), p->in[I_GDN_OUT_NORM] + l * 128, SLOTP(9));
            PH_END
        } else {
            PH_BEGIN_R(R_QKV)
                if (l == 2) { pg8::Gemm g{2048, 2048, 2048}; pg8::SchedDense S; S.init(M_TOK, 3072, c.G, c.bid, SLOTP(1), 2048, WKVP(WKV_KV), 2048);
                  pg8::EpiHeads E{SKVP, 4, TSZ, (1u << 2) | (1u << 4), nullptr, CTAB, STAB};
                  pg8::gemm_phase(ldsl, g, S, E, wid_s * 64 + lane_id()); }
                CTX_REFRESH;
                { pg8::Gemm g{2048, 2048, 2048}; pg8::SchedDense S; S.init(M_TOK, 2048, c.G, c.bid, SLOTP(0), 2048, WBP(WB_MIX_IN), 2048);
                  pg8::EpiHeads E{SLOTP(2), 16, 0, 1u, SLOTP(3), CTAB, STAB};
                  pg8::gemm_phase(ldsl, g, S, E, wid_s * 64 + lane_id()); }
                CTX_REFRESH; skinny_phase<3>(c, SLOTP(0), WBP(WB_SMALL), AUXP(float, AUX_SK), 48, 48);
            PH_END
            if (l == 2) {
                PH_BEGIN_R(R_CMP)
                    pg8::Gemm g{1024, 2048, 4096}; pg8::SchedCmp S{c.G, c.bid, (const char*)SKVP, (const char*)(SKVP + TSZ), (const char*)WKVP(WKV_W1K), (const char*)WKVP(WKV_W1V)};
                    pg8::EpiCmp E{(float*)SLOTP(7)};
                    pg8::gemm_phase(ldsl, g, S, E, wid_s * 64 + lane_id());
                PH_END
                PH_BEGIN_R(R_CMP)
                    cmp_w2_phase(c, (const float*)SLOTP(7), (const float*)(ws + WS_WKV + WKV_BIASK), (const float*)(ws + WS_WKV + WKV_BIASV), WKVP(WKV_W2K), (bf16_t*)(ws + WS_SKV + SKV_KCMP), WKVP(WKV_W2V), (bf16_t*)(ws + WS_SKV + SKV_VCMP));
                PH_END
            }
            PH_BEGIN_R(R_ATT)
                nsa_attn_phase(c, SLOTP(2), SLOTP(3), SKVP, (const bf16_t*)(ws + WS_SKV + SKV_KCMP), (const bf16_t*)(ws + WS_SKV + SKV_VCMP), AUXP(float, AUX_SK), SLOTP(5), SLOTP(6), SLOTP(4));
            PH_END
        }
        PH_BEGIN_R(R_OUT)
            { const bf16_t* A = (l < 2) ? SLOTP(9) : SLOTP(4); const void* base = (l == 0) ? (const void*)p->in[I_X] : (const void*)HP;
              pg8::Gemm g{2048, 2048, 2048}; pg8::SchedDense S; S.init(M_TOK, 2048, c.G, c.bid, A, 2048, WBP(WB_MIX_OUT), 2048);
              pg8::EpiRes E{base, rep_ ? SLOTP(11) : HP, 2048, l == 0};
              pg8::gemm_phase(ldsl, g, S, E, wid_s * 64 + lane_id()); }
        PH_END
        PH_BEGIN
            norm_phase<false, 4>(c, HP, nullptr, nullptr, nullptr, p->in[I_FFN_NORM] + (size_t)l * DM, SLOTP(0), nullptr, nullptr, nullptr);
            if (l & 1) {
                asm volatile("s_waitcnt vmcnt(0)" ::: "memory"); __syncthreads();
                CTX_REFRESH; skinny_phase<1>(c, SLOTP(0), WBP(WB_ROUTER), AUXP(float, AUX_RL), 8, 8);
                asm volatile("s_waitcnt vmcnt(0)" ::: "memory"); __syncthreads();
                CTX_REFRESH; moe_route_phase(c, AUXP(float, AUX_RL), (unsigned*)(ws + WS_CTL) + CW_MOECNT + 64 * (l >> 1), AUXP(int, AUX_TOKE), AUXP(int, AUX_TOKR), AUXP(float, AUX_TOKW));
            }
        PH_END
        if ((l & 1) == 0) {
            PH_BEGIN_R(R_FFNGU)
                { pg8::Gemm g{2048, 2048, 2048}; pg8::SchedDense S; S.init(M_TOK, 2 * FFN, c.G, c.bid, SLOTP(0), 2048, WBP(WB_FFN), 2048);
                  pg8::EpiSwiglu E{SLOTP(1), FFN};
                  pg8::gemm_phase(ldsl, g, S, E, wid_s * 64 + lane_id()); }
            PH_END
            PH_BEGIN_R(R_DOWN)
                { pg8::Gemm g{FFN, FFN, FFN}; pg8::SchedDense S; S.init(M_TOK, 2048, c.G, c.bid, SLOTP(1), FFN, WBP(WB_FFN_DOWN_DENSE), FFN);
                  pg8::EpiRes E{HP, rep_ ? SLOTP(11) : HP, 2048, false};
                  pg8::gemm_phase(ldsl, g, S, E, wid_s * 64 + lane_id()); }
            PH_END
        } else {
            PH_BEGIN_R(R_GATHER)
                moe_gather_phase(c, (unsigned*)(ws + WS_CTL) + CW_MOECNT + 64 * (l >> 1), AUXP(int, AUX_TOKE), AUXP(int, AUX_TOKR), AUXP(float, AUX_TOKW), SLOTP(0), SLOTP(1), AUXP(int, AUX_SLOTOF), AUXP(float, AUX_ROWW), TILE_E);
            PH_END
#pragma unroll 1
            for (int sp = 0; sp < 3; ++sp) {
                PH_BEGIN_R(R_MOEG)
                    { const int nMt = TILE_E[160], T1 = nMt < 112 ? nMt : 112;
                      pg8::Gemm g{2048, 2048, 2048};
                      pg8::SchedMoe2 S{sp == 0 ? 0 : T1, sp == 0 ? T1 : (sp == 1 ? nMt : T1), sp == 1 ? 0 : T1, sp == 0 ? T1 : (sp == 1 ? T1 : nMt), c.G, c.bid,
                                       (const char*)SLOTP(1), (const char*)WBP(WB_FFN), (const char*)SLOTP(4), (const char*)WBP(WB_MOE_DOWN), TILE_E};
                      pg8::EpiMoe E{SLOTP(4), SLOTP(7), AUXP(float, AUX_ROWW)};
                      pg8::gemm_phase(ldsl, g, S, E, wid_s * 64 + lane_id()); }
                PH_END
            }
        }
    }
    PH_BEGIN_R(R_FINAL)
        norm_phase<false, 2>(c, HP, SLOTP(7), AUXP(int, AUX_SLOTOF), nullptr, p->in[I_FINAL_NORM], nullptr, nullptr, nullptr, p->out);
    PH_END
#undef PH_BEGIN
#undef PH_END
}

#ifndef MK_ONE_LAUNCH
#define MK_ONE_LAUNCH 1
#endif
extern "C" void kernel_launch(void* const* d_in, const int* in_sizes, int n_in, void* d_out, int out_size, void* d_ws, size_t ws_size, hipStream_t stream) {
    static int grid = 0;
    if (grid == 0) {
        if (n_in != 28 || out_size != M_TOK * DM || ws_size < WS_END) { fprintf(stderr, "kernel_launch: unexpected shapes (n_in %d out %d ws %zu need %zu)\n", n_in, out_size, ws_size, (size_t)WS_END); grid = -1; return; }
        int dev = 0, cus = 0, per_cu = 0;
        if (hipGetDevice(&dev) != hipSuccess || hipDeviceGetAttribute(&cus, hipDeviceAttributeMultiprocessorCount, dev) != hipSuccess) { grid = -1; return; }
        if (hipFuncSetAttribute((const void*)mega_fwd, hipFuncAttributeMaxDynamicSharedMemorySize, LDS_BYTES) != hipSuccess) { fprintf(stderr, "kernel_launch: hipFuncSetAttribute failed\n"); grid = -1; return; }
        if (hipOccupancyMaxActiveBlocksPerMultiprocessor(&per_cu, (const void*)mega_fwd, NTHREADS, LDS_BYTES) != hipSuccess || per_cu < 1) { fprintf(stderr, "kernel_launch: occupancy query says %d\n", per_cu); }
        (void)hipGetLastError();
        grid = cus;
    }
    if (grid < 0) return;
    if (hipMemsetAsync((char*)d_ws + WS_CTL, 0, 1 * MiB, stream) != hipSuccess) return;
    Params p{};
    for (int i = 0; i < 28; ++i) p.in[i] = (const float*)d_in[i];
    p.out = (float*)d_out; p.ws = (unsigned char*)d_ws;
#if MK_ONE_LAUNCH
    p.ph_lo = 0; p.ph_hi = NPH_MAX;
    hipLaunchKernelGGL(mega_fwd, dim3(grid), dim3(NTHREADS), LDS_BYTES, stream, p);
#else
    for (int i = 0; i < 43; ++i) { p.ph_lo = i; p.ph_hi = i + 1; hipLaunchKernelGGL(mega_fwd, dim3(grid), dim3(NTHREADS), LDS_BYTES, stream, p); }
#endif
}
```
